# Optimizing an MI355X kernel written in HIP

```python
import jax, jax.numpy as jnp
from jax import lax
import numpy as np

D_MODEL = 1024
BATCH = 4
SEQ = 8192
DEPTH = 4

GRID_W = 64
HEAD_DIM = 64
N_RWKV_HEADS = 8
N_ATT_HEADS = 8
RWKV_WIDTH = N_RWKV_HEADS * HEAD_DIM
ATT_WIDTH = N_ATT_HEADS * HEAD_DIM
MIX_WIDTH = RWKV_WIDTH + ATT_WIDTH
DECAY_LORA = 64
AAA_LORA = 64
GATE_LORA = 128
RWKV_COLS = 3 * RWKV_WIDTH + 2 * DECAY_LORA + 2 * AAA_LORA + GATE_LORA
IN_COLS = RWKV_COLS + 3 * ATT_WIDTH
WIN_ROWS_MAX = 8
WIN_COLS = 16
D_FF = ((8 * D_MODEL + 3 * 256 - 1) // (3 * 256)) * 256
NORM_EPS = 1e-6
GN_EPS = 64e-5
N_DIRS = 2

kernel_name = "hybrid_rwkv7_natten_adaln_encoder"


def rms_norm(x, g):
    xf = x.astype(jnp.float32)
    y = xf * lax.rsqrt(jnp.mean(xf * xf, axis=-1, keepdims=True) + NORM_EPS)
    return (y * g).astype(x.dtype)


def centred_shift(z, mu):
    z_prev = jnp.pad(z[:, :-1], ((0, 0), (1, 0), (0, 0)))
    z_next = jnp.pad(z[:, 1:], ((0, 0), (0, 1), (0, 0)))
    return z + mu[0] * (z_prev - z) + mu[1] * (z_next - z)


def wkv7_scan(r, w, k, v, a_neg, b):
    def step(state, inp):
        r_t, w_t, k_t, v_t, an_t, b_t = inp
        sa = jnp.einsum('dbhij,dbhj->dbhi', state, an_t)
        state = (state * w_t[..., None, :] + sa[..., :, None] * b_t[..., None, :]
                 + v_t[..., :, None] * k_t[..., None, :])
        y = jnp.einsum('dbhij,dbhj->dbhi', state, r_t)
        return state, y
    state0 = jnp.zeros(r.shape[1:] + (r.shape[-1],), jnp.float32)
    _, y = lax.scan(step, state0, (r, w, k, v, a_neg, b))
    return y


def rwkv7_bidir(z, w0, w2, a0, a2, g2, k_k, k_a, r_k, lnx_g, lnx_b):
    B_, S_, _ = z.shape
    H, N, RW = N_RWKV_HEADS, HEAD_DIM, RWKV_WIDTH
    z = z.astype(jnp.float32)
    r = z[..., :RW]
    k = z[..., RW:2 * RW]
    v = z[..., 2 * RW:3 * RW]
    o = 3 * RW
    xw = z[..., o:o + 2 * DECAY_LORA].reshape(B_, S_, N_DIRS, DECAY_LORA)
    o += 2 * DECAY_LORA
    xa = z[..., o:o + 2 * AAA_LORA].reshape(B_, S_, N_DIRS, AAA_LORA)
    o += 2 * AAA_LORA
    xg = z[..., o:o + GATE_LORA]
    w_log = -jax.nn.softplus(-(w0 + jnp.einsum('bsdr,drc->bsdc', jnp.tanh(xw), w2))) - 0.5
    decay = jnp.exp(-jnp.exp(w_log))
    a = jax.nn.sigmoid(a0 + jnp.einsum('bsdr,drc->bsdc', xa, a2))
    g = jnp.einsum('bsr,rc->bsc', jax.nn.sigmoid(xg), g2)
    kk = (k * k_k).reshape(B_, S_, H, N)
    kk = kk / jnp.maximum(jnp.sqrt(jnp.sum(kk * kk, axis=-1, keepdims=True)), 1e-12)
    kk = kk.reshape(B_, S_, RW)
    k_dir = k[:, :, None, :] * (1.0 + (a - 1.0) * k_a)

    def both(t):
        return jnp.broadcast_to(t[:, :, None, :], (B_, S_, N_DIRS, RW))

    def to_scan(t):
        t = t.reshape(B_, S_, N_DIRS, H, N).transpose(1, 2, 0, 3, 4)
        return jnp.stack([t[:, 0], t[::-1, 1]], axis=1)

    y = wkv7_scan(to_scan(both(r)), to_scan(decay), to_scan(k_dir), to_scan(both(v)),
                  to_scan(both(-kk)), to_scan(both(kk) * a))
    y = (y[:, 0] + y[::-1, 1]).transpose(1, 0, 2, 3)
    mu = jnp.mean(y, axis=-1, keepdims=True)
    var = jnp.mean(jnp.square(y - mu), axis=-1, keepdims=True)
    yn = ((y - mu) * lax.rsqrt(var + GN_EPS)).reshape(B_, S_, RW) * lnx_g + lnx_b
    r_h = r.reshape(B_, S_, H, N)
    k_sum = jnp.sum(k_dir, axis=2).reshape(B_, S_, H, N)
    coef = jnp.sum(r_h * k_sum * r_k.reshape(H, N), axis=-1, keepdims=True)
    bonus = (coef * v.reshape(B_, S_, H, N)).reshape(B_, S_, RW)
    return (yn + bonus) * g


def head_rms(t, g):
    tf = t.astype(jnp.float32)
    y = tf * lax.rsqrt(jnp.mean(tf * tf, axis=-1, keepdims=True) + NORM_EPS)
    return (y * g).astype(t.dtype)


def neighbourhood_attention(q, k, v, rpb):
    B_, S_, H, Dh = q.shape
    rows = S_ // GRID_W
    kh = min(WIN_ROWS_MAX, rows)
    kw = WIN_COLS
    scale = Dh ** -0.5
    qg = q.reshape(B_, rows, GRID_W, H, Dh).transpose(1, 0, 2, 3, 4)
    kg = k.reshape(B_, rows, GRID_W, H, Dh)
    vg = v.reshape(B_, rows, GRID_W, H, Dh)
    col = jnp.arange(GRID_W)
    col_start = jnp.clip(col - kw // 2, 0, GRID_W - kw)
    col_idx = col_start[:, None] + jnp.arange(kw)[None, :]
    col_off = col_idx - col[:, None] + (WIN_COLS - 1)

    def one_row(args):
        q_row, i = args
        r0 = jnp.clip(i - kh // 2, 0, rows - kh)
        k_nb = lax.dynamic_slice_in_dim(kg, r0, kh, axis=1)[:, :, col_idx]
        v_nb = lax.dynamic_slice_in_dim(vg, r0, kh, axis=1)[:, :, col_idx]
        row_off = r0 + jnp.arange(kh) - i + (WIN_ROWS_MAX - 1)
        bias = rpb[:, row_off][:, :, col_off].transpose(0, 2, 1, 3)
        s = jnp.einsum('bwhd,bkwlhd->bhwkl', q_row, k_nb).astype(jnp.float32) * scale + bias[None]
        p = jax.nn.softmax(s.reshape(B_, H, GRID_W, kh * kw), axis=-1)
        p = p.reshape(B_, H, GRID_W, kh, kw).astype(v.dtype)
        return jnp.einsum('bhwkl,bkwlhd->bwhd', p, v_nb)

    out = lax.map(one_row, (qg, jnp.arange(rows)))
    return out.transpose(1, 0, 2, 3, 4).reshape(B_, S_, H * Dh)


def setup_inputs(seed: int = 0) -> dict:
    key = jax.random.key(seed)
    ks = jax.random.split(key, 26)
    L, D, RW = DEPTH, D_MODEL, RWKV_WIDTH
    nrm = jax.random.normal
    f32 = jnp.float32
    return {
        "x": nrm(ks[0], (BATCH, SEQ, D), f32),
        "c": nrm(ks[1], (BATCH, D), f32),
        "ada_w": nrm(ks[2], (L, D, 6 * D), f32) * (0.5 * D ** -0.5),
        "ada_b": nrm(ks[3], (L, 6 * D), f32) * 0.01,
        "norm1_g": 1.0 + 0.05 * nrm(ks[4], (L, D), f32),
        "norm2_g": 1.0 + 0.05 * nrm(ks[5], (L, D), f32),
        "w_in": nrm(ks[6], (L, D, IN_COLS), f32) * D ** -0.5,
        "shift_mu": jax.random.uniform(ks[7], (L, 2, RWKV_COLS), f32, 0.0, 0.5),
        "w0": jax.random.uniform(ks[8], (L, N_DIRS, RW), f32, -6.0, 1.0),
        "w2": nrm(ks[9], (L, N_DIRS, DECAY_LORA, RW), f32) * (0.5 * DECAY_LORA ** -0.5),
        "a0": 0.5 * nrm(ks[10], (L, N_DIRS, RW), f32),
        "a2": nrm(ks[11], (L, N_DIRS, AAA_LORA, RW), f32) * (0.5 * AAA_LORA ** -0.5),
        "g2": nrm(ks[12], (L, GATE_LORA, RW), f32) * GATE_LORA ** -0.5,
        "k_k": 0.85 + 0.05 * nrm(ks[13], (L, RW), f32),
        "k_a": 1.0 + 0.05 * nrm(ks[14], (L, RW), f32),
        "r_k": 0.1 * nrm(ks[15], (L, RW), f32),
        "lnx_g": 1.0 + 0.05 * nrm(ks[16], (L, RW), f32),
        "lnx_b": 0.01 * nrm(ks[17], (L, RW), f32),
        "q_norm_g": 1.0 + 0.05 * nrm(ks[18], (L, HEAD_DIM), f32),
        "k_norm_g": 1.0 + 0.05 * nrm(ks[19], (L, HEAD_DIM), f32),
        "rpb": 0.1 * nrm(ks[20], (L, N_ATT_HEADS, 2 * WIN_ROWS_MAX - 1, 2 * WIN_COLS - 1), f32),
        "w_out": nrm(ks[21], (L, MIX_WIDTH, D), f32) * MIX_WIDTH ** -0.5,
        "ffn_w_in": nrm(ks[22], (L, D, 2 * D_FF), f32) * D ** -0.5,
        "ffn_w_out": nrm(ks[23], (L, D_FF, D), f32) * D_FF ** -0.5,
    }


def reference(x, c, ada_w, ada_b, norm1_g, norm2_g, w_in, shift_mu, w0, w2, a0, a2, g2,
              k_k, k_a, r_k, lnx_g, lnx_b, q_norm_g, k_norm_g, rpb, w_out, ffn_w_in, ffn_w_out):
    B_, S_, D = x.shape
    c_act = jax.nn.silu(c)
    h = x
    for l in range(DEPTH):
        mod = (c_act @ ada_w[l] + ada_b[l])[:, None, :]
        sh1, sc1, gt1, sh2, sc2, gt2 = jnp.split(mod, 6, axis=-1)
        u = rms_norm(h, norm1_g[l]) * (1.0 + sc1) + sh1
        z = u @ w_in[l]
        z_rwkv = centred_shift(z[..., :RWKV_COLS], shift_mu[l])
        y_rwkv = rwkv7_bidir(z_rwkv, w0[l], w2[l], a0[l], a2[l], g2[l], k_k[l], k_a[l],
                             r_k[l], lnx_g[l], lnx_b[l])
        za = z[..., RWKV_COLS:]
        q = head_rms(za[..., :ATT_WIDTH].reshape(B_, S_, N_ATT_HEADS, HEAD_DIM), q_norm_g[l])
        k = head_rms(za[..., ATT_WIDTH:2 * ATT_WIDTH].reshape(B_, S_, N_ATT_HEADS, HEAD_DIM), k_norm_g[l])
        v = za[..., 2 * ATT_WIDTH:].reshape(B_, S_, N_ATT_HEADS, HEAD_DIM)
        y_att = neighbourhood_attention(q, k, v, rpb[l])
        y = jnp.concatenate([y_rwkv.astype(h.dtype), y_att.astype(h.dtype)], axis=-1) @ w_out[l]
        h = h + gt1 * y
        u = rms_norm(h, norm2_g[l]) * (1.0 + sc2) + sh2
        gu = u @ ffn_w_in[l]
        h = h + gt2 * ((jax.nn.silu(gu[..., :D_FF]) * gu[..., D_FF:]) @ ffn_w_out[l])
    return h
```

```cpp
#include <hip/hip_runtime.h>
#include <hip/hip_cooperative_groups.h>
#include <cstdio>
#include <cstdint>
__device__ __forceinline__ int fresh_tid() { int t = threadIdx.x; asm volatile("" : "+v"(t)); return t; }
namespace pg8 {
#define PG8_LAS __attribute__((address_space(3)))
typedef unsigned short bf16_t;
typedef short bf16x8 __attribute__((ext_vector_type(8)));
typedef float f32x4 __attribute__((ext_vector_type(4)));
typedef unsigned u32x4 __attribute__((ext_vector_type(4)));
constexpr int BM = 256, BK = 64, HALF = 128, HTB = HALF * BK * 2  , STAGE_BYTES = 8 * HTB, NXCD = 8, WGM = 4;

__host__ __device__ __forceinline__ int lds_byte(int r, int c) { const int st = (r >> 4) * 2 + (c >> 5), rr = r & 15, cc = c & 31, ob = rr * 64 + cc * 2; return st * 1024 + (ob ^ (((ob >> 9) & 1) << 5)); }
__host__ __device__ __forceinline__ void stage_rc(int b, int& R, int& C) { const int st = b / 1024, sb = b % 1024, swz = sb ^ (((sb >> 9) & 1) << 5); R = (st >> 1) * 16 + swz / 64; C = (st & 1) * 32 + (swz % 64) / 2; }
__host__ __device__ __forceinline__ int perm32(int rho) { const int n = rho >> 4, i = rho & 15; return 8 * (i >> 2) + 4 * n + (i & 3); }

struct Unit { int pm, pn; };
struct Gemm { const bf16_t* A; const bf16_t* Bt; int M, N, K; };

struct StaticOrder {
    int nM, nN, nwg, G, c;
    __host__ __device__ void init(int M, int N, int G_, int c_) { nM = M / BM; nN = N / BM; nwg = nM * nN; G = G_; c = c_; }
    __host__ __device__ bool next(int i, Unit& u) const {
        const long L = (long)i * G + c; if (L >= nwg) return false;
        int wgid = (int)L; { const int q = nwg / NXCD, r = nwg % NXCD, xcd = wgid % NXCD, off = wgid / NXCD; wgid = (xcd < r ? xcd * (q + 1) : r * (q + 1) + (xcd - r) * q) + off; }
        const int nig = WGM * nN, gid = wgid / nig, fm = gid * WGM, gsz = (nM - fm) < WGM ? (nM - fm) : WGM;
        u.pm = fm + ((wgid % nig) % gsz); u.pn = (wgid % nig) / gsz; return true;
    }
    __device__ __forceinline__ void a_ready(const Unit&) const {}
    __device__ __forceinline__ void done(const Unit&) const {}
};

typedef float f32x2c_t __attribute__((ext_vector_type(2))); typedef __bf16 bf16x2c_t __attribute__((ext_vector_type(2)));
__device__ __forceinline__ unsigned cvt_pk_bf16(float lo, float hi) { f32x2c_t v = {lo, hi}; bf16x2c_t b = __builtin_convertvector(v, bf16x2c_t); return __builtin_bit_cast(unsigned, b); }
typedef float f32x2 __attribute__((ext_vector_type(2)));
template <class Epi, class Sched, bool ALIGN_EPI = false, bool SP2 = false>
__device__ __forceinline__ void gemm_phase(PG8_LAS unsigned char* lds, const Gemm g, const Sched& S, const Epi& E) {
    const int tid = ::fresh_tid(), wid = __builtin_amdgcn_readfirstlane(tid >> 6), lane = tid & 63, wr = wid >> 2, wc = wid & 3, fr = lane & 15, fq = lane >> 4;
    const int K = g.K, nt = K / BK;
    unsigned voffA[2], voffB[2];
#pragma unroll
    for (int i = 0; i < 2; ++i) { int R, C; stage_rc(tid * 16 + i * 8192, R, C); const int Rb = Epi::PERM ? ((R & ~31) + perm32(R & 31)) : R;
        voffA[i] = (unsigned)(R * K + C) * 2u; voffB[i] = (unsigned)(Rb * K + C) * 2u; }
    const size_t kstep = (size_t)(BK * 2);
    const size_t hstep = (size_t)HALF * K * 2;
    const size_t tstep = 2 * hstep;
    const unsigned ldsw = (unsigned)wid * 1024u;
    const int aoff = lds_byte(wr * 64 + fr, fq * 8), boff = lds_byte(wc * 32 + fr, fq * 8);
#define PG8_SA(b, h) (((b) * 2 + (h)) * HTB)
#define PG8_SB(b, h) ((4 + (b) * 2 + (h)) * HTB)
#define PG8_STAGE(bufoff, gbase, voff) do { _Pragma("unroll") for (int _i = 0; _i < 2; ++_i) \
        __builtin_amdgcn_global_load_lds((const unsigned*)((const char*)(gbase) + (voff)[_i]), (PG8_LAS unsigned*)(lds + (bufoff) + ldsw + _i * 8192), 16, 0, 0); } while (0)
#define PG8_LDA(dst, b, h) do { _Pragma("unroll") for (int m = 0; m < 4; ++m) _Pragma("unroll") for (int k = 0; k < 2; ++k) dst[m][k] = *(const PG8_LAS bf16x8*)(lds + PG8_SA(b, h) + aoff + m * 2048 + k * 1024); } while (0)
#define PG8_LDB(dst, b, h) do { _Pragma("unroll") for (int n = 0; n < 2; ++n) _Pragma("unroll") for (int k = 0; k < 2; ++k) dst[n][k] = *(const PG8_LAS bf16x8*)(lds + PG8_SB(b, h) + boff + n * 2048 + k * 1024); } while (0)
#define PG8_MMA(ai, bj, At, Bt) do { __builtin_amdgcn_s_setprio(1); _Pragma("unroll") for (int m = 0; m < 4; ++m) _Pragma("unroll") for (int n = 0; n < 2; ++n) _Pragma("unroll") for (int k = 0; k < 2; ++k) \
        acc[ai][bj][m][n] = __builtin_amdgcn_mfma_f32_16x16x32_bf16(Bt[n][k], At[m][k], acc[ai][bj][m][n], 0, 0, 0); __builtin_amdgcn_s_setprio(0); } while (0)
#define PG8_WAIT_V(n) asm volatile("s_waitcnt vmcnt(" #n ")" ::: "memory")
#define PG8_WAIT_L(n) asm volatile("s_waitcnt lgkmcnt(" #n ")" ::: "memory")
#define PG8_BAR __builtin_amdgcn_s_barrier()
#define PG8_SCHED __builtin_amdgcn_sched_barrier(0)
    Unit cur, nxt; int ui = 0;
    if (!S.next(0, cur)) return;
    f32x4 acc[2][2][4][2];
#pragma unroll
    for (int a = 0; a < 2; ++a)
#pragma unroll
        for (int b = 0; b < 2; ++b)
#pragma unroll
            for (int m = 0; m < 4; ++m)
#pragma unroll
                for (int n = 0; n < 2; ++n) acc[a][b][m][n] = (f32x4){0.f, 0.f, 0.f, 0.f};
    bf16x8 At[4][2], B0[2][2], B1[2][2];
    const char* cA = (const char*)g.A + (size_t)cur.pm * tstep; const char* cB = (const char*)g.Bt + (size_t)cur.pn * tstep;
    S.a_ready(cur);
    if constexpr (SP2) {
        PG8_STAGE(PG8_SB(0, 0), cB, voffB); PG8_STAGE(PG8_SB(0, 1), cB + hstep, voffB); PG8_STAGE(PG8_SA(0, 0), cA, voffA); PG8_STAGE(PG8_SA(0, 1), cA + hstep, voffA);
        if (wr == 1) PG8_BAR;
        PG8_WAIT_V(2); PG8_BAR;
        PG8_STAGE(PG8_SB(1, 0), cB + kstep, voffB); PG8_STAGE(PG8_SA(1, 0), cA + kstep, voffA); PG8_STAGE(PG8_SB(1, 1), cB + hstep + kstep, voffB);
        PG8_WAIT_V(6); PG8_BAR;
    } else {
        PG8_STAGE(PG8_SB(0, 0), cB, voffB); PG8_STAGE(PG8_SA(0, 0), cA, voffA); PG8_STAGE(PG8_SB(0, 1), cB + hstep, voffB); PG8_STAGE(PG8_SA(0, 1), cA + hstep, voffA);
        if (wr == 1) PG8_BAR;
        PG8_WAIT_V(4); PG8_BAR;
        PG8_STAGE(PG8_SB(1, 0), cB + kstep, voffB); PG8_STAGE(PG8_SA(1, 0), cA + kstep, voffA); PG8_STAGE(PG8_SB(1, 1), cB + hstep + kstep, voffB);
        PG8_WAIT_V(6); PG8_BAR;
    }
    for (;;) {
        const bool has_next = S.next(ui + 1, nxt);
        const char* nA = has_next ? (const char*)g.A + (size_t)nxt.pm * tstep : cA; const char* nB = has_next ? (const char*)g.Bt + (size_t)nxt.pn * tstep : cB;
        for (int t = 0; t < nt; t += 2) {
            const bool last = (t == nt - 2);
            const char* a1 = cA + (size_t)(t + 1) * kstep;
            const char* a2 = last ? nA : cA + (size_t)(t + 2) * kstep; const char* b2 = last ? nB : cB + (size_t)(t + 2) * kstep;
            const char* a3 = a2 + kstep; const char* b3 = b2 + kstep;
            if (last && has_next) S.a_ready(nxt);
            if constexpr (SP2) {
            PG8_LDB(B0, 0, 0); PG8_LDB(B1, 0, 1); PG8_SCHED; PG8_LDA(At, 0, 0); PG8_STAGE(PG8_SA(1, 1), a1 + hstep, voffA);
            PG8_WAIT_V(8); PG8_WAIT_L(0); PG8_BAR; PG8_MMA(0, 0, At, B0); PG8_MMA(0, 1, At, B1); PG8_BAR; PG8_SCHED;
            PG8_LDA(At, 0, 1); PG8_STAGE(PG8_SB(0, 0), b2, voffB); PG8_STAGE(PG8_SB(0, 1), b2 + hstep, voffB); PG8_STAGE(PG8_SA(0, 0), a2, voffA);
            PG8_WAIT_V(8); PG8_WAIT_L(0); PG8_BAR; PG8_MMA(1, 0, At, B0); PG8_MMA(1, 1, At, B1); PG8_BAR; PG8_SCHED;
            PG8_LDB(B0, 1, 0); PG8_LDB(B1, 1, 1); PG8_SCHED; PG8_LDA(At, 1, 0); PG8_STAGE(PG8_SA(0, 1), a2 + hstep, voffA);
            PG8_WAIT_V(8); PG8_WAIT_L(0); PG8_BAR; PG8_MMA(0, 0, At, B0); PG8_MMA(0, 1, At, B1); PG8_BAR; PG8_SCHED;
            PG8_LDA(At, 1, 1); PG8_STAGE(PG8_SB(1, 0), b3, voffB); PG8_STAGE(PG8_SB(1, 1), b3 + hstep, voffB); PG8_STAGE(PG8_SA(1, 0), a3, voffA);
            PG8_WAIT_V(8); PG8_WAIT_L(0); PG8_BAR; PG8_MMA(1, 0, At, B0); PG8_MMA(1, 1, At, B1); PG8_BAR; PG8_SCHED;
            } else {
            PG8_LDB(B0, 0, 0); PG8_SCHED; PG8_LDA(At, 0, 0); PG8_STAGE(PG8_SA(1, 1), a1 + hstep, voffA);
            PG8_WAIT_L(8); PG8_BAR; PG8_WAIT_L(0); PG8_MMA(0, 0, At, B0); PG8_BAR; PG8_SCHED;
            PG8_LDB(B1, 0, 1); PG8_STAGE(PG8_SB(0, 0), b2, voffB);
            PG8_BAR; PG8_WAIT_L(0); PG8_MMA(0, 1, At, B1); PG8_BAR;
            PG8_LDA(At, 0, 1); PG8_STAGE(PG8_SA(0, 0), a2, voffA);
            PG8_BAR; PG8_WAIT_L(0); PG8_MMA(1, 0, At, B0); PG8_BAR; PG8_SCHED;
            PG8_STAGE(PG8_SB(0, 1), b2 + hstep, voffB);
            PG8_WAIT_V(6); PG8_BAR; PG8_MMA(1, 1, At, B1); PG8_BAR;
            PG8_LDB(B0, 1, 0); PG8_SCHED; PG8_LDA(At, 1, 0); PG8_STAGE(PG8_SA(0, 1), a2 + hstep, voffA);
            PG8_WAIT_L(8); PG8_BAR; PG8_WAIT_L(0); PG8_MMA(0, 0, At, B0); PG8_BAR; PG8_SCHED;
            PG8_LDB(B1, 1, 1); PG8_STAGE(PG8_SB(1, 0), b3, voffB);
            PG8_BAR; PG8_WAIT_L(0); PG8_MMA(0, 1, At, B1); PG8_BAR;
            PG8_LDA(At, 1, 1); PG8_STAGE(PG8_SA(1, 0), a3, voffA);
            PG8_BAR; PG8_WAIT_L(0); PG8_MMA(1, 0, At, B0); PG8_BAR; PG8_SCHED;
            PG8_STAGE(PG8_SB(1, 1), b3 + hstep, voffB);
            PG8_WAIT_V(6); PG8_BAR; PG8_MMA(1, 1, At, B1); PG8_BAR;
            }
        }
        if constexpr (ALIGN_EPI) { if (wr == 0) PG8_BAR; }
        if constexpr (!Epi::AFTER_DRAIN) { E(acc, cur, wr, wc, fr, fq); S.done(cur); }
        if (!has_next) break;
#pragma unroll
        for (int a = 0; a < 2; ++a)
#pragma unroll
            for (int b = 0; b < 2; ++b)
#pragma unroll
                for (int m = 0; m < 4; ++m)
#pragma unroll
                    for (int n = 0; n < 2; ++n) acc[a][b][m][n] = (f32x4){0.f, 0.f, 0.f, 0.f};
        cur = nxt; cA = nA; cB = nB; ++ui;
        if constexpr (ALIGN_EPI) { if (wr == 1) PG8_BAR; }
    }
    PG8_WAIT_V(0);
    if constexpr (!ALIGN_EPI) { if (wr == 0) PG8_BAR; }
    PG8_BAR;
    if constexpr (Epi::AFTER_DRAIN) { E.fused(acc, cur, wr, wc, fr, fq, lds, wid, lane); S.done(cur); }
#undef PG8_SA
#undef PG8_SB
#undef PG8_STAGE
#undef PG8_LDA
#undef PG8_LDB
#undef PG8_MMA
#undef PG8_WAIT_V
#undef PG8_WAIT_L
#undef PG8_BAR
#undef PG8_SCHED
}
}

namespace cg = cooperative_groups;
using pg8::bf16_t; using pg8::bf16x8; using pg8::f32x4; using pg8::u32x4; using pg8::cvt_pk_bf16;
#define LAS __attribute__((address_space(3)))
typedef unsigned u32x2 __attribute__((ext_vector_type(2)));

constexpr int NB = 4, SEQ = 8192, DM = 1024, MTOK = NB * SEQ, NLAYER = 4;
constexpr int RW = 512, RWKV_COLS = 1920, IN_COLS = 3456, NPAD1 = 3584, DFF = 2816;
constexpr size_t MiB = 1u << 20;
constexpr size_t WS_W1 = 0, WS_W2 = 7 * MiB, WS_W3 = 9 * MiB, WS_W4 = 20 * MiB, WS_MOD = 26 * MiB, WS_COEF = 27 * MiB, WS_RSTD = 28 * MiB;
constexpr size_t WS_WL = 25 * MiB + 512 * 1024;
constexpr size_t WS_QKG = 29 * MiB;
constexpr size_t WS_BAR = 29 * MiB + 65536;
constexpr size_t WS_U = 30 * MiB;
constexpr size_t WS_QK = 94 * MiB, WS_VT = 158 * MiB;
constexpr size_t WS_R = 94 * MiB, WS_K = 126 * MiB, WS_V = 158 * MiB;
constexpr size_t WS_ZR = 190 * MiB;
constexpr size_t WS_E0 = 318 * MiB, WS_E1 = 350 * MiB, WS_A0 = 382 * MiB, WS_A1 = 414 * MiB;
constexpr size_t WS_DELTA = 318 * MiB;
constexpr size_t WS_ACT = 94 * MiB;
constexpr size_t WS_END = 446 * MiB;
constexpr int LDS_BYTES = 147456;
constexpr int NPHASE = 1 + 10 * NLAYER;

struct Params { const float* in[24]; float* out; unsigned char* ws; int lo, hi; };
enum { I_X = 0, I_C, I_ADAW, I_ADAB, I_N1G, I_N2G, I_WIN, I_MU, I_W0, I_W2, I_A0, I_A2, I_G2, I_KK, I_KA, I_RK, I_LNG, I_LNB, I_QG, I_KG, I_RPB, I_WOUT, I_FIN, I_FOUT };

__device__ __forceinline__ int fresh_tid();
__device__ __forceinline__ __amdgpu_buffer_rsrc_t ws_rsrc(unsigned char* ws) { return __builtin_amdgcn_make_buffer_rsrc(ws, 0, 0x20000000, 0x00020000); }
__device__ __forceinline__ void st16_wt(__amdgpu_buffer_rsrc_t r, size_t off, u32x4 v) { __builtin_amdgcn_raw_buffer_store_b128(v, r, (int)off, 0, 16); }
__device__ __forceinline__ float bf2f(unsigned short v) { return __builtin_bit_cast(float, (unsigned)v << 16); }
__device__ __forceinline__ float bflo(unsigned w) { return __builtin_bit_cast(float, w << 16); }
__device__ __forceinline__ float bfhi(unsigned w) { return __builtin_bit_cast(float, w & 0xffff0000u); }
__device__ __forceinline__ unsigned short f2bf(float f) { return (unsigned short)(cvt_pk_bf16(f, 0.f) & 0xffffu); }
__device__ __forceinline__ float wave_sum(float v) {
#pragma unroll
    for (int o = 32; o >= 1; o >>= 1) v += __shfl_xor(v, o);
    return v;
}
__device__ __forceinline__ float sigmoidf_(float x) { return __builtin_amdgcn_rcpf(1.f + __expf(-x)); }
template <int CTRL> __device__ __forceinline__ float dppf(float x) { return __builtin_bit_cast(float, __builtin_amdgcn_update_dpp(0, __builtin_bit_cast(int, x), CTRL, 0xF, 0xF, false)); }
__device__ __forceinline__ float rowsum16(float x) { x += dppf<0x128>(x); x += dppf<0x124>(x); x += dppf<0x122>(x); x += dppf<0x121>(x); return x; }

__device__ __forceinline__ void phase_mod(const Params& p, float* lds) {
    const int tid = fresh_tid();
    const float* c = p.in[I_C]; const float* aw = p.in[I_ADAW]; const float* ab = p.in[I_ADAB];
    float* mod = (float*)(p.ws + WS_MOD);
    for (int i = tid; i < NB * DM; i += 512) { const float v = c[i]; lds[i] = v / (1.f + __expf(-v)); }
    __syncthreads();
    float* red = lds + NB * DM;
    const int cl = tid & 63, kp = tid >> 6;
    for (int item = blockIdx.x; item < NLAYER * 96; item += gridDim.x) {
        const int l = item / 96, n = (item % 96) * 64 + cl;
        const float* wp = aw + ((size_t)l * DM + kp * 128) * 6144 + n;
        float a0 = 0.f, a1 = 0.f, a2 = 0.f, a3 = 0.f;
#pragma unroll 8
        for (int k = 0; k < 128; ++k) { const float w = wp[(size_t)k * 6144]; const int kk = kp * 128 + k;
            a0 += w * lds[kk]; a1 += w * lds[DM + kk]; a2 += w * lds[2 * DM + kk]; a3 += w * lds[3 * DM + kk]; }
        red[(kp * 4 + 0) * 64 + cl] = a0; red[(kp * 4 + 1) * 64 + cl] = a1; red[(kp * 4 + 2) * 64 + cl] = a2; red[(kp * 4 + 3) * 64 + cl] = a3;
        __syncthreads();
        if (tid < 256) { const int b = tid >> 6; float s = ab[l * 6144 + n];
#pragma unroll
            for (int q = 0; q < 8; ++q) s += red[(q * 4 + b) * 64 + cl];
            mod[(size_t)(l * NB + b) * 6144 + n] = s; }
        __syncthreads();
    }
}

__device__ __forceinline__ void phase_conv(const Params& p, int l, float* tile) {
    const int tid = fresh_tid();
    constexpr int T1 = (NPAD1 / 64) * 16, T2 = 16 * 16, T3 = (2 * DFF / 64) * 16, T4 = 16 * (DFF / 64);
    for (int it = blockIdx.x; it < T1 + T2 + T3 + T4; it += gridDim.x) {
        int mode, nt, kt, K, Nsrc; const float* src; bf16_t* dst;
        if (it < T1) { mode = 1; nt = it / 16; kt = it % 16; K = DM; Nsrc = IN_COLS; src = p.in[I_WIN] + (size_t)l * DM * IN_COLS; dst = (bf16_t*)(p.ws + WS_W1); }
        else if (it < T1 + T2) { const int i2 = it - T1; mode = 2; nt = i2 / 16; kt = i2 % 16; K = DM; Nsrc = DM; src = p.in[I_WOUT] + (size_t)l * DM * DM; dst = (bf16_t*)(p.ws + WS_W2); }
        else if (it < T1 + T2 + T3) { const int i3 = it - T1 - T2; mode = 3; nt = i3 / 16; kt = i3 % 16; K = DM; Nsrc = 2 * DFF; src = p.in[I_FIN] + (size_t)l * DM * 2 * DFF; dst = (bf16_t*)(p.ws + WS_W3); }
        else { const int i4 = it - T1 - T2 - T3; mode = 4; nt = i4 / 44; kt = i4 % 44; K = DFF; Nsrc = DM; src = p.in[I_FOUT] + (size_t)l * DFF * DM; dst = (bf16_t*)(p.ws + WS_W4); }
        {
            const int nn = tid & 63, kk = tid >> 6, np = nt * 64 + nn; int col;
            if (mode == 1) { const int pn = np >> 8, pp = np & 255, bj = pp >> 7, wc = (pp >> 5) & 3, cc = pp & 31; const int L = 256 * pn + 64 * wc + 32 * bj + cc;
                col = L < 1536 ? RWKV_COLS + L : (L < IN_COLS ? L - 1536 : -1); }
            else if (mode == 3) { const int pn = np >> 8, bj = (np >> 7) & 1, i = np & 127; col = bj * DFF + 128 * pn + i; }
            else col = np;
#pragma unroll
            for (int kr = 0; kr < 8; ++kr) { const int k = kk + 8 * kr; tile[k * 65 + nn] = col >= 0 ? src[(size_t)(kt * 64 + k) * Nsrc + col] : 0.f; }
        }
        __syncthreads();
        {
            const int nn = tid >> 3, kc = tid & 7; u32x4 w;
            w.x = cvt_pk_bf16(tile[(8 * kc + 0) * 65 + nn], tile[(8 * kc + 1) * 65 + nn]); w.y = cvt_pk_bf16(tile[(8 * kc + 2) * 65 + nn], tile[(8 * kc + 3) * 65 + nn]);
            w.z = cvt_pk_bf16(tile[(8 * kc + 4) * 65 + nn], tile[(8 * kc + 5) * 65 + nn]); w.w = cvt_pk_bf16(tile[(8 * kc + 6) * 65 + nn], tile[(8 * kc + 7) * 65 + nn]);
            *(u32x4*)(dst + (size_t)(nt * 64 + nn) * K + kt * 64 + 8 * kc) = w;
        }
        __syncthreads();
    }
    {
        bf16_t* WL = (bf16_t*)(p.ws + WS_WL);
        for (int idx = blockIdx.x * 512 + tid; idx < 512 * 48; idx += gridDim.x * 512) { const int col = idx & 511, kc = idx >> 9, k0 = 8 * kc;
            const float* src;
            if (k0 < 128) src = p.in[I_W2] + ((size_t)(l * 2 + (k0 >> 6)) * 64 + (k0 & 63)) * RW + col;
            else if (k0 < 256) src = p.in[I_A2] + ((size_t)(l * 2 + ((k0 - 128) >> 6)) * 64 + (k0 & 63)) * RW + col;
            else src = p.in[I_G2] + ((size_t)l * 128 + (k0 - 256)) * RW + col;
            u32x4 w; w.x = cvt_pk_bf16(src[0], src[RW]); w.y = cvt_pk_bf16(src[2 * RW], src[3 * RW]); w.z = cvt_pk_bf16(src[4 * RW], src[5 * RW]); w.w = cvt_pk_bf16(src[6 * RW], src[7 * RW]);
            *(u32x4*)(WL + (size_t)col * 384 + k0) = w; }
    }
}

__device__ __forceinline__ void phase_norm(const Params& p, int l, int which, const float* h, float* lds) {
    const int tid = fresh_tid(), lane = tid & 63, wave = tid >> 6;
    const float* mod = (const float*)(p.ws + WS_MOD) + (size_t)l * NB * 6144;
    const float* g = p.in[which == 0 ? I_N1G : I_N2G] + l * DM;
    float* gs = lds; float* sh = lds + NB * DM; float* g1 = lds + 2 * NB * DM;
    const bf16_t* delta = (const bf16_t*)(p.ws + WS_DELTA);
    if (which == 0 && blockIdx.x == 0 && tid < 128) ((float*)(p.ws + WS_QKG))[tid] = tid < 64 ? p.in[I_QG][l * 64 + tid] : p.in[I_KG][l * 64 + tid - 64];
    for (int i = tid; i < NB * DM; i += 512) { const int b = i >> 10, k = i & 1023;
        gs[i] = g[k] * (1.f + mod[b * 6144 + (which * 3 + 1) * DM + k]); sh[i] = mod[b * 6144 + (which * 3) * DM + k]; g1[i] = mod[b * 6144 + 2 * DM + k]; }
    __syncthreads();
    bf16_t* u = (bf16_t*)(p.ws + WS_U);
    const int stride = gridDim.x * 8;
    for (int row0 = blockIdx.x * 8 + wave; row0 < MTOK; row0 += 2 * stride) {
        const int row1 = row0 + stride < MTOK ? row0 + stride : row0;
        const float* hr0 = h + (size_t)row0 * DM; const float* hr1 = h + (size_t)row1 * DM;
        f32x4 v0[4], v1[4]; float ss0 = 0.f, ss1 = 0.f;
#pragma unroll
        for (int q = 0; q < 4; ++q) { v0[q] = *(const f32x4*)(hr0 + 4 * lane + 256 * q); v1[q] = *(const f32x4*)(hr1 + 4 * lane + 256 * q); }
        if (which == 1) {
            const int bb0 = row0 >> 13, bb1 = row1 >> 13;
#pragma unroll
            for (int q = 0; q < 4; ++q) { const int k = 4 * lane + 256 * q;
                const u32x2 d0 = *(const u32x2*)(delta + (size_t)row0 * DM + k), d1 = *(const u32x2*)(delta + (size_t)row1 * DM + k);
                const f32x4 ga = *(const f32x4*)(g1 + bb0 * DM + k), gb = *(const f32x4*)(g1 + bb1 * DM + k);
                v0[q] += ga * (f32x4){bflo(d0.x), bfhi(d0.x), bflo(d0.y), bfhi(d0.y)}; v1[q] += gb * (f32x4){bflo(d1.x), bfhi(d1.x), bflo(d1.y), bfhi(d1.y)}; }
        }
#pragma unroll
        for (int q = 0; q < 4; ++q) { ss0 += v0[q][0] * v0[q][0] + v0[q][1] * v0[q][1] + v0[q][2] * v0[q][2] + v0[q][3] * v0[q][3]; ss1 += v1[q][0] * v1[q][0] + v1[q][1] * v1[q][1] + v1[q][2] * v1[q][2] + v1[q][3] * v1[q][3]; }
        ss0 = wave_sum(ss0); ss1 = wave_sum(ss1);
        const float rstd0 = rsqrtf(ss0 * (1.f / DM) + 1e-6f), rstd1 = rsqrtf(ss1 * (1.f / DM) + 1e-6f);
        const int b0 = row0 >> 13, b1 = row1 >> 13;
#pragma unroll
        for (int q = 0; q < 4; ++q) { const int k = 4 * lane + 256 * q;
            { const f32x4 gg = *(const f32x4*)(gs + b0 * DM + k), ss4 = *(const f32x4*)(sh + b0 * DM + k);
              const f32x4 o = v0[q] * rstd0 * gg + ss4; u32x2 w; w.x = cvt_pk_bf16(o[0], o[1]); w.y = cvt_pk_bf16(o[2], o[3]); *(u32x2*)(u + (size_t)row0 * DM + k) = w; }
            { const f32x4 gg = *(const f32x4*)(gs + b1 * DM + k), ss4 = *(const f32x4*)(sh + b1 * DM + k);
              const f32x4 o = v1[q] * rstd1 * gg + ss4; u32x2 w; w.x = cvt_pk_bf16(o[0], o[1]); w.y = cvt_pk_bf16(o[2], o[3]); *(u32x2*)(u + (size_t)row1 * DM + k) = w; }
        }
    }
}

struct EpiZ {
    static constexpr bool PERM = true, AFTER_DRAIN = false;
    unsigned char* ws;
    __device__ __forceinline__ void operator()(const f32x4 (&acc)[2][2][4][2], const pg8::Unit& u, int wr, int wc, int fr, int fq) const {
        const int pn = u.pn, row0 = u.pm * 256 + wr * 64 + fr;
        bf16_t* qk = (bf16_t*)(ws + WS_QK); bf16_t* vT = (bf16_t*)(ws + WS_VT); bf16_t* zr = (bf16_t*)(ws + WS_ZR);
        const __amdgpu_buffer_rsrc_t rs = ws_rsrc(ws);
        if (pn < 4) {
            const float* gg = (const float*)(ws + WS_QKG) + (pn < 2 ? 0 : 64); const float sc = pn < 2 ? 0.125f : 1.f;
            f32x4 gv[2][2];
#pragma unroll
            for (int bj = 0; bj < 2; ++bj)
#pragma unroll
                for (int n = 0; n < 2; ++n) gv[bj][n] = *(const f32x4*)(gg + 32 * bj + 8 * fq + 4 * n) * sc;
            asm volatile("s_waitcnt vmcnt(0)" ::: "memory");
#pragma unroll
            for (int ai = 0; ai < 2; ++ai)
#pragma unroll
                for (int m = 0; m < 4; ++m) {
                    float ss = 0.f;
#pragma unroll
                    for (int bj = 0; bj < 2; ++bj)
#pragma unroll
                        for (int n = 0; n < 2; ++n) { const f32x4 a = acc[ai][bj][m][n]; ss += a[0] * a[0] + a[1] * a[1] + a[2] * a[2] + a[3] * a[3]; }
                    ss += __shfl_xor(ss, 16); ss += __shfl_xor(ss, 32);
                    const float rstd = rsqrtf(ss * (1.f / 64.f) + 1e-6f);
                    bf16_t* rowp = qk + (size_t)(row0 + ai * 128 + m * 16) * 1024 + pn * 256 + 64 * wc + 8 * fq;
#pragma unroll
                    for (int bj = 0; bj < 2; ++bj) { const f32x4 v0 = acc[ai][bj][m][0] * rstd * gv[bj][0], v1 = acc[ai][bj][m][1] * rstd * gv[bj][1];
                        u32x4 w; w.x = cvt_pk_bf16(v0[0], v0[1]); w.y = cvt_pk_bf16(v0[2], v0[3]); w.z = cvt_pk_bf16(v1[0], v1[1]); w.w = cvt_pk_bf16(v1[2], v1[3]);
                        st16_wt(rs, (size_t)((const unsigned char*)(rowp + 32 * bj) - ws), w); }
                }
        } else if (pn < 6) {
            const int h = (pn - 4) * 4 + wc;
#pragma unroll
            for (int ai = 0; ai < 2; ++ai)
#pragma unroll
                for (int m = 0; m < 4; ++m) { const int row = row0 + ai * 128 + m * 16, b = row >> 13, t = row & 8191;
                    bf16_t* base = vT + ((size_t)(b * 8 + h) * 64 + 8 * fq) * SEQ + t;
#pragma unroll
                    for (int bj = 0; bj < 2; ++bj)
#pragma unroll
                        for (int n = 0; n < 2; ++n)
#pragma unroll
                            for (int j = 0; j < 4; ++j) base[(size_t)(32 * bj + 4 * n + j) * SEQ] = f2bf(acc[ai][bj][m][n][j]);
                }
        } else {
            const int colbase = (pn - 6) * 256 + 64 * wc + 8 * fq;
#pragma unroll
            for (int ai = 0; ai < 2; ++ai)
#pragma unroll
                for (int m = 0; m < 4; ++m) { bf16_t* rowp = zr + (size_t)(row0 + ai * 128 + m * 16) * 2048 + colbase;
#pragma unroll
                    for (int bj = 0; bj < 2; ++bj) { const f32x4 v0 = acc[ai][bj][m][0], v1 = acc[ai][bj][m][1];
                        u32x4 w; w.x = cvt_pk_bf16(v0[0], v0[1]); w.y = cvt_pk_bf16(v0[2], v0[3]); w.z = cvt_pk_bf16(v1[0], v1[1]); w.w = cvt_pk_bf16(v1[2], v1[3]);
                        st16_wt(rs, (size_t)((const unsigned char*)(rowp + 32 * bj) - ws), w); }
                }
        }
    }
};

struct EpiRes {
    static constexpr bool PERM = true, AFTER_DRAIN = false;
    const float* hin; float* hout; unsigned char* ws; int gate_off; int gate1_off;
    __device__ __forceinline__ void operator()(const f32x4 (&acc)[2][2][4][2], const pg8::Unit& u, int wr, int wc, int fr, int fq) const {
        const int row0 = u.pm * 256 + wr * 64 + fr, col0 = u.pn * 256 + wc * 32 + 8 * fq, b = (u.pm * 256) >> 13;
        const float* gate = (const float*)(ws + WS_MOD) + gate_off;
        const float* gate1 = (const float*)(ws + WS_MOD) + (gate1_off < 0 ? 0 : gate1_off);
        const bf16_t* delta = (const bf16_t*)(ws + WS_DELTA);
        f32x4 gv[2][2], g1[2][2];
#pragma unroll
        for (int bj = 0; bj < 2; ++bj)
#pragma unroll
            for (int n = 0; n < 2; ++n) { gv[bj][n] = *(const f32x4*)(gate + b * 6144 + col0 + 128 * bj + 4 * n); g1[bj][n] = *(const f32x4*)(gate1 + b * 6144 + col0 + 128 * bj + 4 * n); }
#pragma unroll
        for (int ai = 0; ai < 2; ++ai)
#pragma unroll
            for (int m = 0; m < 4; ++m) { const size_t ro = (size_t)(row0 + ai * 128 + m * 16) * DM + col0;
#pragma unroll
                for (int bj = 0; bj < 2; ++bj) {
                    f32x4 h0 = *(const f32x4*)(hin + ro + 128 * bj), h1 = *(const f32x4*)(hin + ro + 128 * bj + 4);
                    if (gate1_off >= 0) { const u32x4 dw = *(const u32x4*)(delta + ro + 128 * bj);
                        h0 += g1[bj][0] * (f32x4){bflo(dw.x), bfhi(dw.x), bflo(dw.y), bfhi(dw.y)}; h1 += g1[bj][1] * (f32x4){bflo(dw.z), bfhi(dw.z), bflo(dw.w), bfhi(dw.w)}; }
                    *(f32x4*)(hout + ro + 128 * bj) = h0 + gv[bj][0] * acc[ai][bj][m][0];
                    *(f32x4*)(hout + ro + 128 * bj + 4) = h1 + gv[bj][1] * acc[ai][bj][m][1]; }
            }
    }
};

struct EpiDelta {
    static constexpr bool PERM = true, AFTER_DRAIN = false;
    unsigned char* ws;
    __device__ __forceinline__ void operator()(const f32x4 (&acc)[2][2][4][2], const pg8::Unit& u, int wr, int wc, int fr, int fq) const {
        const int row0 = u.pm * 256 + wr * 64 + fr, col0 = u.pn * 256 + wc * 32 + 8 * fq; bf16_t* delta = (bf16_t*)(ws + WS_DELTA);
        const __amdgpu_buffer_rsrc_t rs = ws_rsrc(ws);
#pragma unroll
        for (int ai = 0; ai < 2; ++ai)
#pragma unroll
            for (int m = 0; m < 4; ++m) { bf16_t* rowp = delta + (size_t)(row0 + ai * 128 + m * 16) * DM + col0;
#pragma unroll
                for (int bj = 0; bj < 2; ++bj) { const f32x4 v0 = acc[ai][bj][m][0], v1 = acc[ai][bj][m][1];
                    u32x4 w; w.x = cvt_pk_bf16(v0[0], v0[1]); w.y = cvt_pk_bf16(v0[2], v0[3]); w.z = cvt_pk_bf16(v1[0], v1[1]); w.w = cvt_pk_bf16(v1[2], v1[3]);
                    st16_wt(rs, (size_t)((const unsigned char*)(rowp + 128 * bj) - ws), w); }
            }
    }
};

struct EpiSwiglu {
    static constexpr bool PERM = true, AFTER_DRAIN = false;
    unsigned char* ws;
    __device__ __forceinline__ void operator()(const f32x4 (&acc)[2][2][4][2], const pg8::Unit& u, int wr, int wc, int fr, int fq) const {
        const int row0 = u.pm * 256 + wr * 64 + fr, col0 = u.pn * 128 + wc * 32 + 8 * fq; const __amdgpu_buffer_rsrc_t rs = ws_rsrc(ws);
#pragma unroll
        for (int ai = 0; ai < 2; ++ai)
#pragma unroll
            for (int m = 0; m < 4; ++m) { float o[8];
#pragma unroll
                for (int n = 0; n < 2; ++n)
#pragma unroll
                    for (int j = 0; j < 4; ++j) { const float gte = acc[ai][0][m][n][j], up = acc[ai][1][m][n][j]; o[4 * n + j] = gte * __builtin_amdgcn_rcpf(1.f + __expf(-gte)) * up; }
                u32x4 w; w.x = cvt_pk_bf16(o[0], o[1]); w.y = cvt_pk_bf16(o[2], o[3]); w.z = cvt_pk_bf16(o[4], o[5]); w.w = cvt_pk_bf16(o[6], o[7]);
                st16_wt(rs, WS_ACT + ((size_t)(row0 + ai * 128 + m * 16) * DFF + col0) * 2, w); }
    }
};

struct EpiAny {
    static constexpr bool PERM = true, AFTER_DRAIN = false;
    int mode; unsigned char* ws; const float* hin; float* hout; int gate_off; int gate1_off;
    __device__ __forceinline__ void operator()(const f32x4 (&acc)[2][2][4][2], const pg8::Unit& u, int wr, int wc, int fr, int fq) const {
        if (mode == 0) { EpiZ E{ws}; E(acc, u, wr, wc, fr, fq); }
        else if (mode == 1) { EpiRes E{hin, hout, ws, gate_off, gate1_off}; E(acc, u, wr, wc, fr, fq); }
        else if (mode == 3) { EpiDelta E{ws}; E(acc, u, wr, wc, fr, fq); }
        else { EpiSwiglu E{ws}; E(acc, u, wr, wc, fr, fq); }
    }
};

__device__ __forceinline__ void phase_attn(const Params& p, int l, float* lds) {
    const int tid = fresh_tid(), lane = tid & 63, wave = tid >> 6, fr = lane & 15, fq = lane >> 4;
    const float* rpb = p.in[I_RPB] + (size_t)l * 8 * 15 * 31;
    for (int i = tid; i < 8 * 15 * 31; i += 512) lds[i] = rpb[i];
    __syncthreads();
    const bf16_t* qk = (const bf16_t*)(p.ws + WS_QK); const bf16_t* vT = (const bf16_t*)(p.ws + WS_VT); bf16_t* ymix = (bf16_t*)(p.ws + WS_U);
    for (int task = blockIdx.x * 8 + wave; task < NB * 128 * 8 * 4; task += gridDim.x * 8) {
        const int g = task & 3, h = (task >> 2) & 7, i = (task >> 5) & 127, b = task >> 12;
        const int r0 = min(max(i - 4, 0), 120), c0 = g == 0 ? 0 : (g == 1 ? 8 : (g == 2 ? 24 : 32));
        const int qcol = 16 * g + fr, cs = min(max(qcol - 8, 0), 48);
        const size_t qtok = (size_t)b * SEQ + i * 64 + qcol;
        bf16x8 qf[2];
        qf[0] = *(const bf16x8*)(qk + qtok * 1024 + h * 64 + 8 * fq); qf[1] = *(const bf16x8*)(qk + qtok * 1024 + h * 64 + 32 + 8 * fq);
        const int kcolA = c0 + 8 * (fr >> 2) + (fr & 3);
        const bf16_t* kbase = qk + ((size_t)b * SEQ + r0 * 64 + kcolA) * 1024 + 512 + h * 64 + 8 * fq;
        const bf16_t* vbase = vT + ((size_t)(b * 8 + h) * 64 + fr) * SEQ + r0 * 64 + c0 + 8 * fq;
        bf16x8 kf[8][2][2];
#pragma unroll
        for (int kr = 0; kr < 8; ++kr)
#pragma unroll
            for (int blk = 0; blk < 2; ++blk) { const bf16_t* kp = kbase + (size_t)(kr * 64 + 4 * blk) * 1024; kf[kr][blk][0] = *(const bf16x8*)kp; kf[kr][blk][1] = *(const bf16x8*)(kp + 32); }
        __builtin_amdgcn_sched_barrier(0);
        float sc[8][8];
#pragma unroll
        for (int kr = 0; kr < 8; ++kr)
#pragma unroll
            for (int blk = 0; blk < 2; ++blk) {
                f32x4 a = {0.f, 0.f, 0.f, 0.f};
                a = __builtin_amdgcn_mfma_f32_16x16x32_bf16(kf[kr][blk][0], qf[0], a, 0, 0, 0);
                a = __builtin_amdgcn_mfma_f32_16x16x32_bf16(kf[kr][blk][1], qf[1], a, 0, 0, 0);
#pragma unroll
                for (int j = 0; j < 4; ++j) sc[kr][4 * blk + j] = a[j];
            }
        __builtin_amdgcn_sched_barrier(0);
        bf16x8 vfa[2][8];
#pragma unroll
        for (int db = 0; db < 2; ++db)
#pragma unroll
            for (int kr = 0; kr < 8; ++kr) vfa[db][kr] = *(const bf16x8*)(vbase + (size_t)(16 * db) * SEQ + kr * 64);
        __builtin_amdgcn_sched_barrier(0);
        float mx = -1e30f;
#pragma unroll
        for (int kr = 0; kr < 8; ++kr) { const int ro = r0 + kr - i + 7;
#pragma unroll
            for (int e = 0; e < 8; ++e) { const int kc = c0 + 8 * fq + e; const bool valid = (kc >= cs) && (kc < cs + 16); const int co = min(max(kc - qcol + 15, 0), 30);
                const float s = valid ? sc[kr][e] + lds[(h * 15 + ro) * 31 + co] : -1e30f; sc[kr][e] = s; mx = fmaxf(mx, s); } }
        mx = fmaxf(mx, __shfl_xor(mx, 16)); mx = fmaxf(mx, __shfl_xor(mx, 32));
        float sum = 0.f; bf16x8 pf[8];
#pragma unroll
        for (int kr = 0; kr < 8; ++kr) { float pe[8];
#pragma unroll
            for (int e = 0; e < 8; ++e) { pe[e] = __builtin_amdgcn_exp2f((sc[kr][e] - mx) * 1.4426950408889634f); sum += pe[e]; }
            u32x4 w; w.x = cvt_pk_bf16(pe[0], pe[1]); w.y = cvt_pk_bf16(pe[2], pe[3]); w.z = cvt_pk_bf16(pe[4], pe[5]); w.w = cvt_pk_bf16(pe[6], pe[7]);
            pf[kr] = __builtin_bit_cast(bf16x8, w); }
        sum += __shfl_xor(sum, 16); sum += __shfl_xor(sum, 32);
        const float inv = 1.f / sum;
        __builtin_amdgcn_sched_barrier(0);
        bf16x8 vfb[2][8];
#pragma unroll
        for (int db = 0; db < 2; ++db)
#pragma unroll
            for (int kr = 0; kr < 8; ++kr) vfb[db][kr] = *(const bf16x8*)(vbase + (size_t)(16 * (db + 2)) * SEQ + kr * 64);
        __builtin_amdgcn_sched_barrier(0);
        f32x4 o[4];
#pragma unroll
        for (int db = 0; db < 4; ++db) { o[db] = (f32x4){0.f, 0.f, 0.f, 0.f};
#pragma unroll
            for (int kr = 0; kr < 8; ++kr) o[db] = __builtin_amdgcn_mfma_f32_16x16x32_bf16(db < 2 ? vfa[db & 1][kr] : vfb[db & 1][kr], pf[kr], o[db], 0, 0, 0); }
        asm volatile("s_waitcnt vmcnt(0)" ::: "memory");
#pragma unroll
        for (int db = 0; db < 4; ++db) { u32x2 w; w.x = cvt_pk_bf16(o[db][0] * inv, o[db][1] * inv); w.y = cvt_pk_bf16(o[db][2] * inv, o[db][3] * inv);
            *(u32x2*)(ymix + qtok * 1024 + 512 + h * 64 + 16 * db + 4 * fq) = w; }
    }
}

constexpr int PT = 32, PSTR = 392;
constexpr int PC_OFF = 6400;
__device__ __forceinline__ float fast_tanh(float x) { return 1.f - 2.f * __builtin_amdgcn_rcpf(1.f + __expf(2.f * x)); }
__device__ __forceinline__ void phase_prep(const Params& p, int l, float* ldsf) {
    const int tid = fresh_tid(), wave = __builtin_amdgcn_readfirstlane(tid >> 6);
    bf16_t* lact = (bf16_t*)ldsf;
    float* cmu0 = ldsf + PC_OFF; float* cmu1 = cmu0 + 1920; float* ckk = cmu1 + 1920; float* cka = ckk + 512; float* crk = cka + 512; float* cw0 = crk + 512; float* ca0 = cw0 + 1024;
    const bf16_t* zr = (const bf16_t*)(p.ws + WS_ZR); const bf16_t* WL = (const bf16_t*)(p.ws + WS_WL);
    bf16_t* R = (bf16_t*)(p.ws + WS_R); bf16_t* K = (bf16_t*)(p.ws + WS_K); bf16_t* V = (bf16_t*)(p.ws + WS_V);
    bf16_t* ymix = (bf16_t*)(p.ws + WS_U); float* coef = (float*)(p.ws + WS_COEF); float* rstdp = (float*)(p.ws + WS_RSTD);
    for (int i = tid; i < 3840; i += 512) cmu0[i] = p.in[I_MU][(size_t)l * 3840 + i];
    for (int i = tid; i < 512; i += 512) { ckk[i] = p.in[I_KK][l * RW + i]; cka[i] = p.in[I_KA][l * RW + i]; crk[i] = p.in[I_RK][l * RW + i]; }
    for (int i = tid; i < 1024; i += 512) { cw0[i] = p.in[I_W0][l * 1024 + i]; ca0[i] = p.in[I_A0][l * 1024 + i]; }
    __syncthreads();
    unsigned zc1[12], zp1[12], zn1[12];
#define PREP_S1_LOAD(TILE) do { int t_ = tid; asm volatile("" : "+v"(t_)); \
        _Pragma("unroll") for (int i = 0; i < 12; ++i) { const int idx = t_ + 512 * i, tt = idx / 192, c2 = idx - tt * 192; \
            const bf16_t* zc_p = zr + (size_t)((TILE) * PT + tt) * 2048 + 1536 + 2 * c2; \
            zc1[i] = *(const unsigned*)(zc_p); zp1[i] = *(const unsigned*)(zc_p - 2048); zn1[i] = *(const unsigned*)(zc_p + 2048); } } while (0)
    if ((int)blockIdx.x < MTOK / PT) PREP_S1_LOAD(blockIdx.x);
    for (int tile = blockIdx.x; tile < MTOK / PT; tile += gridDim.x) {
        const int m0 = tile * PT;
        int lane = tid & 63; asm volatile("" : "+v"(lane));
        const int fr = lane & 15, fq = lane >> 4;
        asm volatile("s_waitcnt vmcnt(0)" ::: "memory");
        { int t_ = tid; asm volatile("" : "+v"(t_));
#pragma unroll
        for (int i = 0; i < 12; ++i) { const int idx = t_ + 512 * i, tt = idx / 192, c2 = idx - tt * 192, m = m0 + tt, t = m & 8191, col = 1536 + 2 * c2;
            const unsigned zc = zc1[i], zp = zp1[i], zn = zn1[i];
            const float pmask = t == 0 ? 0.f : 1.f, nmask = t == SEQ - 1 ? 0.f : 1.f;
            const float2 m0v = *(const float2*)(cmu0 + col), m1v = *(const float2*)(cmu1 + col);
            float v0 = bflo(zc) + m0v.x * (bflo(zp) * pmask - bflo(zc)) + m1v.x * (bflo(zn) * nmask - bflo(zc));
            float v1 = bfhi(zc) + m0v.y * (bfhi(zp) * pmask - bfhi(zc)) + m1v.y * (bfhi(zn) * nmask - bfhi(zc));
            if (c2 < 64) { v0 = fast_tanh(v0); v1 = fast_tanh(v1); } else if (c2 >= 128) { v0 = sigmoidf_(v0); v1 = sigmoidf_(v1); }
            *(unsigned*)(lact + tt * PSTR + 2 * c2) = cvt_pk_bf16(v0, v1); } }
        if (tile + (int)gridDim.x < MTOK / PT) PREP_S1_LOAD(tile + gridDim.x);
        __syncthreads();
        f32x4 asum[2][4];
        const bf16_t* wlb = WL + (size_t)(64 * wave + 8 * (fr >> 2) + (fr & 3)) * 384 + 8 * fq;
#pragma unroll
        for (int o = 0; o < 5; ++o) {
            f32x4 acc[2][4];
#pragma unroll
            for (int mb = 0; mb < 2; ++mb)
#pragma unroll
                for (int nb = 0; nb < 4; ++nb) acc[mb][nb] = (f32x4){0.f, 0.f, 0.f, 0.f};
            const int ks0 = o < 4 ? 2 * o : 8;
            bf16x8 wf[4][4];
#pragma unroll
            for (int kk = 0; kk < 4; ++kk)
#pragma unroll
                for (int nb = 0; nb < 4; ++nb) if (kk < (o < 4 ? 2 : 4)) wf[kk][nb] = *(const bf16x8*)(wlb + (size_t)(32 * (nb >> 1) + 4 * (nb & 1)) * 384 + 32 * (ks0 + kk));
            __builtin_amdgcn_sched_barrier(0);
            asm volatile("s_waitcnt vmcnt(0)" ::: "memory");
#pragma unroll
            for (int kk = 0; kk < 4; ++kk) if (kk < (o < 4 ? 2 : 4)) { const int ks = ks0 + kk;
                bf16x8 af[2];
#pragma unroll
                for (int mb = 0; mb < 2; ++mb) af[mb] = *(const bf16x8*)(lact + (16 * mb + fr) * PSTR + 32 * ks + 8 * fq);
#pragma unroll
                for (int mb = 0; mb < 2; ++mb)
#pragma unroll
                    for (int nb = 0; nb < 4; ++nb) acc[mb][nb] = __builtin_amdgcn_mfma_f32_16x16x32_bf16(wf[kk][nb], af[mb], acc[mb][nb], 0, 0, 0);
            }
#pragma unroll
            for (int np = 0; np < 2; ++np) { const int col = 64 * wave + 32 * np + 8 * fq;
                f32x4 bias0 = {0.f, 0.f, 0.f, 0.f}, bias1 = {0.f, 0.f, 0.f, 0.f};
                if (o < 2) { bias0 = *(const f32x4*)(cw0 + o * RW + col); bias1 = *(const f32x4*)(cw0 + o * RW + col + 4); }
                else if (o < 4) { bias0 = *(const f32x4*)(ca0 + (o - 2) * RW + col); bias1 = *(const f32x4*)(ca0 + (o - 2) * RW + col + 4); }
#pragma unroll
                for (int mb = 0; mb < 2; ++mb) { const size_t m = (size_t)(m0 + 16 * mb + fr); f32x4 v0 = acc[mb][2 * np] + bias0, v1 = acc[mb][2 * np + 1] + bias1;
                    if (o < 4) {
#pragma unroll
                        for (int j = 0; j < 4; ++j) { v0[j] = sigmoidf_(v0[j]); v1[j] = sigmoidf_(v1[j]); }
                        if (o < 2) { v0 = v0 * 0.6065306597126334f; v1 = v1 * 0.6065306597126334f; }
                        else if (o == 2) { asum[mb][2 * np] = v0; asum[mb][2 * np + 1] = v1; } else { asum[mb][2 * np] += v0; asum[mb][2 * np + 1] += v1; } }
                    u32x4 w; w.x = cvt_pk_bf16(v0[0], v0[1]); w.y = cvt_pk_bf16(v0[2], v0[3]); w.z = cvt_pk_bf16(v1[0], v1[1]); w.w = cvt_pk_bf16(v1[2], v1[3]);
                    bf16_t* dst = o == 4 ? ymix + m * 1024 + col : (bf16_t*)(p.ws + (o == 0 ? WS_E0 : (o == 1 ? WS_E1 : (o == 2 ? WS_A0 : WS_A1)))) + m * RW + col;
                    *(u32x4*)dst = w; }
            }
            __builtin_amdgcn_sched_barrier(0);
        }
#pragma unroll
        for (int mb = 0; mb < 2; ++mb) { const int m = m0 + 16 * mb + fr, t = m & 8191; float ssq = 0.f, cf = 0.f;
            const int lc = 64 * wave + 8 * fq;
            const bf16_t* zc_p = zr + (size_t)m * 2048 + lc; const bf16_t* zp_p = zc_p - 2048; const bf16_t* zn_p = zc_p + 2048;
            const float pmask = t == 0 ? 0.f : 1.f, nmask = t == SEQ - 1 ? 0.f : 1.f;
            bf16_t* Rp = R + (size_t)m * RW + lc; bf16_t* Kp = K + (size_t)m * RW + lc; bf16_t* Vp = V + (size_t)m * RW + lc;
            u32x4 zcv[2][3], zpv[2][3], znv[2][3];
#pragma unroll
            for (int np = 0; np < 2; ++np)
#pragma unroll
                for (int part = 0; part < 3; ++part) { const int co = part * 512 + 32 * np; zcv[np][part] = *(const u32x4*)(zc_p + co); zpv[np][part] = *(const u32x4*)(zp_p + co); znv[np][part] = *(const u32x4*)(zn_p + co); }
            __builtin_amdgcn_sched_barrier(0);
            asm volatile("s_waitcnt vmcnt(0)" ::: "memory");
#pragma unroll
            for (int np = 0; np < 2; ++np) { float rr[8], kx[8];
#pragma unroll
                for (int part = 0; part < 3; ++part) { const int co = part * 512 + 32 * np;
                    const u32x4 zc = zcv[np][part], zp = zpv[np][part], zn = znv[np][part];
                    float o8[8];
#pragma unroll
                    for (int hf = 0; hf < 2; ++hf) { const f32x4 m0v = *(const f32x4*)(cmu0 + lc + co + 4 * hf), m1v = *(const f32x4*)(cmu1 + lc + co + 4 * hf);
                        const unsigned c0_ = hf ? zc.z : zc.x, c1_ = hf ? zc.w : zc.y, p0_ = hf ? zp.z : zp.x, p1_ = hf ? zp.w : zp.y, n0_ = hf ? zn.z : zn.x, n1_ = hf ? zn.w : zn.y;
                        float c4[4] = {bflo(c0_), bfhi(c0_), bflo(c1_), bfhi(c1_)}, p4[4] = {bflo(p0_), bfhi(p0_), bflo(p1_), bfhi(p1_)}, n4[4] = {bflo(n0_), bfhi(n0_), bflo(n1_), bfhi(n1_)};
#pragma unroll
                        for (int j = 0; j < 4; ++j) o8[4 * hf + j] = c4[j] + m0v[j] * (p4[j] * pmask - c4[j]) + m1v[j] * (n4[j] * nmask - c4[j]); }
                    u32x4 w; w.x = cvt_pk_bf16(o8[0], o8[1]); w.y = cvt_pk_bf16(o8[2], o8[3]); w.z = cvt_pk_bf16(o8[4], o8[5]); w.w = cvt_pk_bf16(o8[6], o8[7]);
                    *(u32x4*)((part == 0 ? Rp : (part == 1 ? Kp : Vp)) + 32 * np) = w;
                    if (part == 0) {
#pragma unroll
                        for (int e = 0; e < 8; ++e) rr[e] = o8[e]; }
                    if (part == 1) {
#pragma unroll
                        for (int e = 0; e < 8; ++e) kx[e] = o8[e]; }
                }
#pragma unroll
                for (int hf = 0; hf < 2; ++hf) { const f32x4 kk4 = *(const f32x4*)(ckk + lc + 32 * np + 4 * hf), ka4 = *(const f32x4*)(cka + lc + 32 * np + 4 * hf), rk4 = *(const f32x4*)(crk + lc + 32 * np + 4 * hf);
#pragma unroll
                    for (int j = 0; j < 4; ++j) { const float kq = kx[4 * hf + j] * kk4[j]; ssq += kq * kq; cf += rr[4 * hf + j] * kx[4 * hf + j] * (2.f + (asum[mb][2 * np + hf][j] - 2.f) * ka4[j]) * rk4[j]; } }
            }
            ssq += __shfl_xor(ssq, 16); ssq += __shfl_xor(ssq, 32); cf += __shfl_xor(cf, 16); cf += __shfl_xor(cf, 32);
            if (fq == 0) { rstdp[(size_t)m * 8 + wave] = 1.f / fmaxf(sqrtf(ssq), 1e-12f); coef[(size_t)m * 8 + wave] = cf; }
            __builtin_amdgcn_sched_barrier(0);
        }
        __syncthreads();
    }
}

constexpr int ST = 32, SSTR = 336;
constexpr int YP_OFF = 2 * ST * SSTR;
typedef float f32x2_t __attribute__((ext_vector_type(2)));
#define SCAN_LOAD(CH, RW_, KW_, EW_, AW_, RS_, VW_) do { \
    _Pragma("unroll") for (int i = 0; i < 4; ++i) { const int tt = sg + 8 * i, s_ = (CH) * ST + tt, t_ = d ? SEQ - 1 - s_ : s_; const size_t m_ = (size_t)b * SEQ + t_; \
        RW_[i] = *(const unsigned*)(R + m_ * RW + h * 64 + 2 * j2); KW_[i] = *(const unsigned*)(K + m_ * RW + h * 64 + 2 * j2); \
        EW_[i] = *(const unsigned*)(E + m_ * RW + h * 64 + 2 * j2); AW_[i] = *(const unsigned*)(A + m_ * RW + h * 64 + 2 * j2); RS_[i] = rstdp[m_ * 8 + h]; } \
    { const int s_ = (CH) * ST + tv, t_ = d ? SEQ - 1 - s_ : s_; const size_t m_ = (size_t)b * SEQ + t_; VW_ = *(const unsigned*)(V + m_ * RW + h * 64 + 16 * rg + 2 * vi2); } } while (0)
__device__ __forceinline__ void phase_scan(const Params& p, int l, float* lds) {
    const int tid = fresh_tid(), lane = tid & 63, wave = tid >> 6;
    const bf16_t* R = (const bf16_t*)(p.ws + WS_R); const bf16_t* K = (const bf16_t*)(p.ws + WS_K); const bf16_t* V = (const bf16_t*)(p.ws + WS_V);
    const float* rstdp = (const float*)(p.ws + WS_RSTD);
    constexpr int NCH = SEQ / ST;
    for (int item = blockIdx.x; item < 256; item += gridDim.x) {
        const int chain = (item & 7) + 8 * (item >> 5), rg = (item >> 3) & 3, d = chain >> 5, b = (chain >> 3) & 3, h = chain & 7;
        const bf16_t* E = (const bf16_t*)(p.ws + (d ? WS_E1 : WS_E0)); const bf16_t* A = (const bf16_t*)(p.ws + (d ? WS_A1 : WS_A0));
        float* ydir = (float*)(p.ws + WS_ZR) + (size_t)d * MTOK * RW;
        if (wave >= 4) {
            const int lt = tid - 256, j2 = lt & 31, sg = lt >> 5, tv = lt >> 3, vi2 = lt & 7;
            const float kk0 = p.in[I_KK][l * RW + h * 64 + 2 * j2], kk1 = p.in[I_KK][l * RW + h * 64 + 2 * j2 + 1];
            const float ka0 = p.in[I_KA][l * RW + h * 64 + 2 * j2], ka1 = p.in[I_KA][l * RW + h * 64 + 2 * j2 + 1];
            unsigned rwA[4], kwA[4], ewA[4], awA[4], vwA; float rsA[4];
            SCAN_LOAD(0, rwA, kwA, ewA, awA, rsA, vwA);
            for (int ch = 0; ch < NCH + 2; ++ch) {
                asm volatile("s_waitcnt vmcnt(0)" ::: "memory");
                if (ch < NCH) {
                    float* buf = lds + (ch & 1) * ST * SSTR;
#pragma unroll
                    for (int i = 0; i < 4; ++i) { const int tt = sg + 8 * i;
                        const float k0 = bflo(kwA[i]), k1 = bfhi(kwA[i]), a0 = bflo(awA[i]), a1 = bfhi(awA[i]);
                        const float q0 = k0 * kk0 * rsA[i], q1 = k1 * kk1 * rsA[i];
                        float* bp = buf + tt * SSTR + 2 * j2;
                        *(float2*)(bp) = make_float2(__expf(-bflo(ewA[i])), __expf(-bfhi(ewA[i])));
                        *(float2*)(bp + 64) = make_float2(k0 * (1.f + (a0 - 1.f) * ka0), k1 * (1.f + (a1 - 1.f) * ka1));
                        *(float2*)(bp + 128) = make_float2(q0 * a0, q1 * a1);
                        *(float2*)(bp + 192) = make_float2(q0, q1);
                        *(float2*)(bp + 256) = make_float2(bflo(rwA[i]), bfhi(rwA[i])); }
                    *(float2*)(buf + tv * SSTR + 320 + 2 * vi2) = make_float2(bflo(vwA), bfhi(vwA));
                }
                if (ch >= 2) {
                    const float* yp = lds + YP_OFF + (((ch & 1) * ST + tv) * 16 + 2 * vi2) * 8;
                    const f32x4 p0 = *(const f32x4*)(yp), p1 = *(const f32x4*)(yp + 4), p2 = *(const f32x4*)(yp + 8), p3 = *(const f32x4*)(yp + 12);
                    const float ya = (p0[0] + p0[1]) + (p0[2] + p0[3]) + (p1[0] + p1[1]) + (p1[2] + p1[3]);
                    const float yb = (p2[0] + p2[1]) + (p2[2] + p2[3]) + (p3[0] + p3[1]) + (p3[2] + p3[3]);
                    const int s_ = (ch - 2) * ST + tv, t_ = d ? SEQ - 1 - s_ : s_;
                    *(float2*)(ydir + ((size_t)b * SEQ + t_) * RW + h * 64 + 16 * rg + 2 * vi2) = make_float2(ya, yb);
                }
                if (ch + 1 < NCH) SCAN_LOAD(ch + 1, rwA, kwA, ewA, awA, rsA, vwA);
                __syncthreads();
            }
        } else {
            const int cgp = lane >> 4, q = lane & 15;
            f32x2_t s01 = {0.f, 0.f}, s23 = {0.f, 0.f};
            for (int ch = 0; ch < NCH + 2; ++ch) {
                if (ch >= 1 && ch <= NCH) {
                    const float* buf = lds + ((ch - 1) & 1) * ST * SSTR;
                    float* ypw = lds + YP_OFF + ((((ch - 1) & 1) * ST) * 16 + 4 * wave + cgp) * 8 + (q & 7);
                    const float* bq = buf + 4 * q; const float* bvp = buf + 320 + 4 * wave + cgp;
                    f32x4 w4 = *(const f32x4*)(bq), kd = *(const f32x4*)(bq + 64), bv = *(const f32x4*)(bq + 128), kk = *(const f32x4*)(bq + 192), r4 = *(const f32x4*)(bq + 256);
                    float vv = bvp[0];
                    f32x4 w4n = *(const f32x4*)(bq + SSTR), kdn = *(const f32x4*)(bq + SSTR + 64), bvn = *(const f32x4*)(bq + SSTR + 128), kkn = *(const f32x4*)(bq + SSTR + 192), r4n = *(const f32x4*)(bq + SSTR + 256);
                    float vvn = bvp[SSTR];
#pragma unroll
                    for (int tt = 0; tt < ST; ++tt) {
                        const int tn = tt + 2 < ST ? tt + 2 : ST - 1; const float* nb = bq + tn * SSTR;
                        const f32x4 w4m = *(const f32x4*)(nb), kdm = *(const f32x4*)(nb + 64), bvm = *(const f32x4*)(nb + 128), kkm = *(const f32x4*)(nb + 192), r4m = *(const f32x4*)(nb + 256);
                        const float vvm = bvp[tn * SSTR];
                        f32x2_t p2 = s01 * kk.xy; p2 = s23 * kk.zw + p2;
                        float pp = p2.x + p2.y;
                        pp = rowsum16(pp);
                        const f32x2_t vv2 = {vv, vv}, npp = {-pp, -pp};
                        f32x2_t t01 = s01 * w4.xy + vv2 * kd.xy, t23 = s23 * w4.zw + vv2 * kd.zw;
                        s01 = npp * bv.xy + t01; s23 = npp * bv.zw + t23;
                        f32x2_t q2 = s01 * r4.xy; q2 = s23 * r4.zw + q2;
                        float yq = q2.x + q2.y;
                        yq += dppf<0x128>(yq);
                        ypw[tt * 128] = yq;
                        w4 = w4n; kd = kdn; bv = bvn; kk = kkn; r4 = r4n; vv = vvn;
                        w4n = w4m; kdn = kdm; bvn = bvm; kkn = kkm; r4n = r4m; vvn = vvm;
                    }
                }
                __syncthreads();
            }
        }
        __syncthreads();
    }
}

__device__ __forceinline__ void phase_post(const Params& p, int l) {
    const int tid = fresh_tid(), lane = tid & 63, wave = tid >> 6, c = 8 * lane, hd = lane >> 3;
    const float* y0 = (const float*)(p.ws + WS_ZR); const float* y1 = y0 + (size_t)MTOK * RW;
    const bf16_t* V = (const bf16_t*)(p.ws + WS_V); const float* coef = (const float*)(p.ws + WS_COEF); bf16_t* ymix = (bf16_t*)(p.ws + WS_U);
    float lg[8], lb[8];
#pragma unroll
    for (int e = 0; e < 8; ++e) { lg[e] = p.in[I_LNG][l * RW + c + e]; lb[e] = p.in[I_LNB][l * RW + c + e]; }
    const int stride = gridDim.x * 8; const __amdgpu_buffer_rsrc_t wsr = ws_rsrc(p.ws);
    for (int mA = blockIdx.x * 8 + wave; mA < MTOK; mA += 2 * stride) {
        const int mB = mA + stride < MTOK ? mA + stride : mA;
        f32x4 ya[2][2], yb[2][2]; u32x4 vw[2], gw[2]; float cf[2];
#pragma unroll
        for (int r = 0; r < 2; ++r) { const size_t m = (size_t)(r ? mB : mA);
            ya[r][0] = *(const f32x4*)(y0 + m * RW + c); ya[r][1] = *(const f32x4*)(y0 + m * RW + c + 4); yb[r][0] = *(const f32x4*)(y1 + m * RW + c); yb[r][1] = *(const f32x4*)(y1 + m * RW + c + 4);
            vw[r] = *(const u32x4*)(V + m * RW + c); gw[r] = *(const u32x4*)(ymix + m * 1024 + c); cf[r] = coef[m * 8 + hd]; }
        asm volatile("s_waitcnt vmcnt(0)" ::: "memory");
#pragma unroll
        for (int r = 0; r < 2; ++r) { const size_t m = (size_t)(r ? mB : mA);
            float y[8];
#pragma unroll
            for (int e = 0; e < 4; ++e) { y[e] = ya[r][0][e] + yb[r][0][e]; y[4 + e] = ya[r][1][e] + yb[r][1][e]; }
            float s1 = 0.f;
#pragma unroll
            for (int e = 0; e < 8; ++e) s1 += y[e];
            s1 += __shfl_xor(s1, 1); s1 += __shfl_xor(s1, 2); s1 += __shfl_xor(s1, 4);
            const float mean = s1 * (1.f / 64.f);
            float s2 = 0.f;
#pragma unroll
            for (int e = 0; e < 8; ++e) { y[e] -= mean; s2 += y[e] * y[e]; }
            s2 += __shfl_xor(s2, 1); s2 += __shfl_xor(s2, 2); s2 += __shfl_xor(s2, 4);
            const float rs = rsqrtf(s2 * (1.f / 64.f) + 64e-5f);
            float o[8];
#pragma unroll
            for (int e = 0; e < 4; ++e) { const unsigned vv = vw[r][e], gg = gw[r][e];
                o[2 * e] = (y[2 * e] * rs * lg[2 * e] + lb[2 * e] + cf[r] * bflo(vv)) * bflo(gg);
                o[2 * e + 1] = (y[2 * e + 1] * rs * lg[2 * e + 1] + lb[2 * e + 1] + cf[r] * bfhi(vv)) * bfhi(gg); }
            u32x4 w; w.x = cvt_pk_bf16(o[0], o[1]); w.y = cvt_pk_bf16(o[2], o[3]); w.z = cvt_pk_bf16(o[4], o[5]); w.w = cvt_pk_bf16(o[6], o[7]);
            if (r == 0 || mB != mA) st16_wt(wsr, WS_U + (m * 1024 + c) * 2, w);
        }
    }
}

__device__ __forceinline__ void fast_grid_barrier(unsigned* bar, unsigned k) {
    asm volatile("s_waitcnt vmcnt(0)" ::: "memory");
    __syncthreads();
    if (threadIdx.x == 0) {
        const unsigned G = gridDim.x, g = blockIdx.x & 7u, ng = G < 8u ? G : 8u, gsz = (G + 7u - g) >> 3;
        __builtin_amdgcn_fence(__ATOMIC_RELEASE, "agent");
        asm volatile("s_waitcnt vmcnt(0)" ::: "memory");
        const unsigned old = __hip_atomic_fetch_add(bar + 64 * (g + 1), 1u, __ATOMIC_RELAXED, __HIP_MEMORY_SCOPE_AGENT);
        if (old + 1u == k * gsz) __hip_atomic_fetch_add(bar, 1u, __ATOMIC_RELAXED, __HIP_MEMORY_SCOPE_AGENT);
        unsigned spins = 0;
        while (__hip_atomic_load(bar, __ATOMIC_RELAXED, __HIP_MEMORY_SCOPE_AGENT) < k * ng) { __builtin_amdgcn_s_sleep(1); if (++spins > (1u << 22)) break; }
        __builtin_amdgcn_fence(__ATOMIC_ACQUIRE, "agent");
        asm volatile("s_waitcnt vmcnt(0)" ::: "memory");
    }
    __syncthreads();
}

#ifndef GA
#define GA true
#endif
#ifndef GS
#define GS true
#endif
#ifndef PROBE_S
#define PROBE_S -1
#endif
#ifndef PHM
#define PHM 0xFFFF
#endif
#ifndef ONE_LAUNCH
#define ONE_LAUNCH 1
#endif
__global__ void __launch_bounds__(512, 2) hybrid_fwd(Params p_) {
    extern __shared__ __attribute__((aligned(16))) unsigned char lds_raw[];
    float* ldsf = (float*)lds_raw;
    LAS unsigned char* ldsa = (LAS unsigned char*)lds_raw;
    const int G = gridDim.x, bx = blockIdx.x;
    const int ph_lo = p_.lo, ph_hi = p_.hi;
    for (int ph = ph_lo; ph < ph_hi; ++ph) {
        typedef const __attribute__((address_space(4))) Params* kparg_t;
        kparg_t pp = (kparg_t)__builtin_amdgcn_kernarg_segment_ptr();
        asm volatile("" : "+s"(pp));
        Params p;
#pragma unroll
        for (int i = 0; i < 24; ++i) p.in[i] = pp->in[i];
        p.out = pp->out; p.ws = pp->ws; p.lo = ph_lo; p.hi = ph_hi;
        if (ph == 0) { if (blockIdx.x == 0 && threadIdx.x < 9) ((unsigned*)(p.ws + WS_BAR))[64 * threadIdx.x] = 0u;
            if (PHM & 0x400) phase_mod(p, ldsf); __syncthreads(); phase_conv(p, 0, ldsf); }
        else {
            const int l = (ph - 1) / 10, s = (ph - 1) % 10;
            for (int rep = 0; rep < (s == PROBE_S ? 2 : 1); ++rep) {
            if (rep) __syncthreads();
            if (s == 1 || s == 6 || s == 8 || s == 9) {
                if (PHM & 2) {
                const int mode = s == 1 ? 0 : (s == 8 ? 2 : (s == 6 ? 3 : 1));
                const size_t aoff = s == 9 ? WS_ACT : WS_U, boff = s == 1 ? WS_W1 : (s == 6 ? WS_W2 : (s == 8 ? WS_W3 : WS_W4));
                const int N = s == 1 ? NPAD1 : (s == 8 ? 2 * DFF : DM), K = s == 9 ? DFF : DM;
                pg8::Gemm g{(const bf16_t*)(p.ws + aoff), (const bf16_t*)(p.ws + boff), MTOK, N, K}; pg8::StaticOrder S; S.init(MTOK, N, G, bx);
                EpiAny E{mode, p.ws, l == 0 ? p.in[I_X] : p.out, p.out, l * NB * 6144 + 5 * DM, l * NB * 6144 + 2 * DM};
                pg8::gemm_phase<EpiAny, pg8::StaticOrder, GA, GS>(ldsa, g, S, E);
                }
            } else switch (s) {
            case 0: if (PHM & 1) { if (l > 0) phase_conv(p, l, ldsf); __syncthreads(); phase_norm(p, l, 0, l == 0 ? p.in[I_X] : p.out, ldsf); } break;
            case 2: if (PHM & 4) phase_attn(p, l, ldsf); break;
            case 3: if (PHM & 8) phase_prep(p, l, ldsf); break;
            case 4: if (PHM & 16) phase_scan(p, l, ldsf); break;
            case 5: if (PHM & 32) phase_post(p, l); break;
            case 7: if (PHM & 128) phase_norm(p, l, 1, l == 0 ? p.in[I_X] : p.out, ldsf); break;
            }
            }
        }
        __syncthreads();
#if ONE_LAUNCH
        if (ph + 1 < ph_hi) { if (ph == 0) cg::this_grid().sync(); else fast_grid_barrier((unsigned*)(p.ws + WS_BAR), (unsigned)ph); }
#endif
    }
}

extern "C" void kernel_launch(void* const* d_in, const int* in_sizes, int n_in, void* d_out, int out_size, void* d_ws, size_t ws_size, hipStream_t stream) {
    static int grid = 0;
    if (grid == 0) {
        if (n_in != 24 || out_size != MTOK * DM || ws_size < WS_END) { fprintf(stderr, "kernel_launch: unexpected shapes / workspace (n_in %d, out %d, ws %zu)\n", n_in, out_size, ws_size); grid = -1; return; }
        int dev = 0, cus = 0;
        if (hipGetDevice(&dev) != hipSuccess || hipDeviceGetAttribute(&cus, hipDeviceAttributeMultiprocessorCount, dev) != hipSuccess) { grid = -1; return; }
        if (hipFuncSetAttribute((const void*)hybrid_fwd, hipFuncAttributeMaxDynamicSharedMemorySize, LDS_BYTES) != hipSuccess) { grid = -1; return; }
        grid = cus;
    }
    if (grid < 0) return;
    Params p{};
    for (int i = 0; i < 24; ++i) p.in[i] = (const float*)d_in[i];
    p.out = (float*)d_out; p.ws = (unsigned char*)d_ws;
#if ONE_LAUNCH
    p.lo = 0; p.hi = NPHASE;
    void* args[] = {&p};
    hipError_t e = hipLaunchCooperativeKernel((const void*)hybrid_fwd, dim3(grid), dim3(512), args, LDS_BYTES, stream);
    if (e != hipSuccess) fprintf(stderr, "cooperative launch failed: %s (grid %d)\n", hipGetErrorString(e), grid);
#else
    for (int ph = 0; ph < NPHASE; ++ph) { p.lo = ph; p.hi = ph + 1; hipLaunchKernelGGL(hybrid_fwd, dim3(grid), dim3(512), LDS_BYTES, stream, p); }
#endif
}
```

```cpp
#include <hip/hip_runtime.h>
#include <hip/hip_cooperative_groups.h>
#include <cstdio>
#include <cstdint>
__device__ __forceinline__ int fresh_tid() { int t = threadIdx.x; asm volatile("" : "+v"(t)); return t; }
namespace pg8 {
#define PG8_LAS __attribute__((address_space(3)))
typedef unsigned short bf16_t;
typedef short bf16x8 __attribute__((ext_vector_type(8)));
typedef float f32x4 __attribute__((ext_vector_type(4)));
typedef unsigned u32x4 __attribute__((ext_vector_type(4)));
constexpr int BM = 256, BK = 64, HALF = 128, HTB = HALF * BK * 2  , STAGE_BYTES = 8 * HTB, NXCD = 8, WGM = 8;

__host__ __device__ __forceinline__ int lds_byte(int r, int c) { const int st = (r >> 4) * 2 + (c >> 5), rr = r & 15, cc = c & 31, ob = rr * 64 + cc * 2; return st * 1024 + (ob ^ (((ob >> 9) & 1) << 5)); }
__host__ __device__ __forceinline__ void stage_rc(int b, int& R, int& C) { const int st = b / 1024, sb = b % 1024, swz = sb ^ (((sb >> 9) & 1) << 5); R = (st >> 1) * 16 + swz / 64; C = (st & 1) * 32 + (swz % 64) / 2; }
__host__ __device__ __forceinline__ int perm32(int rho) { const int n = rho >> 4, i = rho & 15; return 8 * (i >> 2) + 4 * n + (i & 3); }

struct Unit { int pm, pn; };
struct Gemm { const bf16_t* A; const bf16_t* Bt; int M, N, K; };

struct StaticOrder {
    int nM, nN, nwg, G, c;
    __host__ __device__ void init(int M, int N, int G_, int c_) { nM = M / BM; nN = N / BM; nwg = nM * nN; G = G_; c = c_; }
    __host__ __device__ bool next(int i, Unit& u) const {
        const long L = (long)i * G + c; if (L >= nwg) return false;
        int wgid = (int)L; { const int q = nwg / NXCD, r = nwg % NXCD, xcd = wgid % NXCD, off = wgid / NXCD; wgid = (xcd < r ? xcd * (q + 1) : r * (q + 1) + (xcd - r) * q) + off; }
        const int nig = WGM * nN, gid = wgid / nig, fm = gid * WGM, gsz = (nM - fm) < WGM ? (nM - fm) : WGM;
        u.pm = fm + ((wgid % nig) % gsz); u.pn = (wgid % nig) / gsz; return true;
    }
    __device__ __forceinline__ void a_ready(const Unit&) const {}
    __device__ __forceinline__ void done(const Unit&) const {}
};

typedef float f32x2c_t __attribute__((ext_vector_type(2))); typedef __bf16 bf16x2c_t __attribute__((ext_vector_type(2)));
__device__ __forceinline__ unsigned cvt_pk_bf16(float lo, float hi) { f32x2c_t v = {lo, hi}; bf16x2c_t b = __builtin_convertvector(v, bf16x2c_t); return __builtin_bit_cast(unsigned, b); }
typedef float f32x2 __attribute__((ext_vector_type(2)));
template <class Epi, class Sched, bool ALIGN_EPI = false, bool SP2 = false>
__device__ __forceinline__ void gemm_phase(PG8_LAS unsigned char* lds, const Gemm g, const Sched& S, const Epi& E) {
    const int tid = ::fresh_tid(), wid = __builtin_amdgcn_readfirstlane(tid >> 6), lane = tid & 63, wr = wid >> 2, wc = wid & 3, fr = lane & 15, fq = lane >> 4;
    const int K = g.K, nt = K / BK;
    unsigned voffA[2], voffB[2];
#pragma unroll
    for (int i = 0; i < 2; ++i) { int R, C; stage_rc(tid * 16 + i * 8192, R, C); const int Rb = Epi::PERM ? ((R & ~31) + perm32(R & 31)) : R;
        voffA[i] = (unsigned)(R * K + C) * 2u; voffB[i] = (unsigned)(Rb * K + C) * 2u; }
    const size_t kstep = (size_t)(BK * 2);
    const size_t hstep = (size_t)HALF * K * 2;
    const size_t tstep = 2 * hstep;
    const unsigned ldsw = (unsigned)wid * 1024u;
    const int aoff = lds_byte(wr * 64 + fr, fq * 8), boff = lds_byte(wc * 32 + fr, fq * 8);
#define PG8_SA(b, h) (((b) * 2 + (h)) * HTB)
#define PG8_SB(b, h) ((4 + (b) * 2 + (h)) * HTB)
#define PG8_STAGE(bufoff, gbase, voff) do { _Pragma("unroll") for (int _i = 0; _i < 2; ++_i) \
        __builtin_amdgcn_global_load_lds((const unsigned*)((const char*)(gbase) + (voff)[_i]), (PG8_LAS unsigned*)(lds + (bufoff) + ldsw + _i * 8192), 16, 0, 0); } while (0)
#define PG8_LDA(dst, b, h) do { _Pragma("unroll") for (int m = 0; m < 4; ++m) _Pragma("unroll") for (int k = 0; k < 2; ++k) dst[m][k] = *(const PG8_LAS bf16x8*)(lds + PG8_SA(b, h) + aoff + m * 2048 + k * 1024); } while (0)
#define PG8_LDB(dst, b, h) do { _Pragma("unroll") for (int n = 0; n < 2; ++n) _Pragma("unroll") for (int k = 0; k < 2; ++k) dst[n][k] = *(const PG8_LAS bf16x8*)(lds + PG8_SB(b, h) + boff + n * 2048 + k * 1024); } while (0)
#define PG8_MMA(ai, bj, At, Bt) do { __builtin_amdgcn_s_setprio(1); _Pragma("unroll") for (int m = 0; m < 4; ++m) _Pragma("unroll") for (int n = 0; n < 2; ++n) _Pragma("unroll") for (int k = 0; k < 2; ++k) \
        acc[ai][bj][m][n] = __builtin_amdgcn_mfma_f32_16x16x32_bf16(Bt[n][k], At[m][k], acc[ai][bj][m][n], 0, 0, 0); __builtin_amdgcn_s_setprio(0); } while (0)
#define PG8_WAIT_V(n) asm volatile("s_waitcnt vmcnt(" #n ")" ::: "memory")
#define PG8_WAIT_L(n) asm volatile("s_waitcnt lgkmcnt(" #n ")" ::: "memory")
#define PG8_BAR __builtin_amdgcn_s_barrier()
#define PG8_SCHED __builtin_amdgcn_sched_barrier(0)
    Unit cur, nxt; int ui = 0;
    if (!S.next(0, cur)) return;
    f32x4 acc[2][2][4][2];
#pragma unroll
    for (int a = 0; a < 2; ++a)
#pragma unroll
        for (int b = 0; b < 2; ++b)
#pragma unroll
            for (int m = 0; m < 4; ++m)
#pragma unroll
                for (int n = 0; n < 2; ++n) acc[a][b][m][n] = (f32x4){0.f, 0.f, 0.f, 0.f};
    bf16x8 At[4][2], B0[2][2], B1[2][2];
    const char* cA = (const char*)g.A + (size_t)cur.pm * tstep; const char* cB = (const char*)g.Bt + (size_t)cur.pn * tstep;
    S.a_ready(cur);
    if constexpr (SP2) {
        PG8_STAGE(PG8_SB(0, 0), cB, voffB); PG8_STAGE(PG8_SB(0, 1), cB + hstep, voffB); PG8_STAGE(PG8_SA(0, 0), cA, voffA); PG8_STAGE(PG8_SA(0, 1), cA + hstep, voffA);
        if (wr == 1) PG8_BAR;
        PG8_WAIT_V(2); PG8_BAR;
        PG8_STAGE(PG8_SB(1, 0), cB + kstep, voffB); PG8_STAGE(PG8_SA(1, 0), cA + kstep, voffA); PG8_STAGE(PG8_SB(1, 1), cB + hstep + kstep, voffB);
        PG8_WAIT_V(6); PG8_BAR;
    } else {
        PG8_STAGE(PG8_SB(0, 0), cB, voffB); PG8_STAGE(PG8_SA(0, 0), cA, voffA); PG8_STAGE(PG8_SB(0, 1), cB + hstep, voffB); PG8_STAGE(PG8_SA(0, 1), cA + hstep, voffA);
        if (wr == 1) PG8_BAR;
        PG8_WAIT_V(4); PG8_BAR;
        PG8_STAGE(PG8_SB(1, 0), cB + kstep, voffB); PG8_STAGE(PG8_SA(1, 0), cA + kstep, voffA); PG8_STAGE(PG8_SB(1, 1), cB + hstep + kstep, voffB);
        PG8_WAIT_V(6); PG8_BAR;
    }
    for (;;) {
        const bool has_next = S.next(ui + 1, nxt);
        const char* nA = has_next ? (const char*)g.A + (size_t)nxt.pm * tstep : cA; const char* nB = has_next ? (const char*)g.Bt + (size_t)nxt.pn * tstep : cB;
        for (int t = 0; t < nt; t += 2) {
            const bool last = (t == nt - 2);
            const char* a1 = cA + (size_t)(t + 1) * kstep;
            const char* a2 = last ? nA : cA + (size_t)(t + 2) * kstep; const char* b2 = last ? nB : cB + (size_t)(t + 2) * kstep;
            const char* a3 = a2 + kstep; const char* b3 = b2 + kstep;
            if (last && has_next) S.a_ready(nxt);
            if constexpr (SP2) {
            PG8_LDB(B0, 0, 0); PG8_LDB(B1, 0, 1); PG8_SCHED; PG8_LDA(At, 0, 0); PG8_STAGE(PG8_SA(1, 1), a1 + hstep, voffA);
            PG8_WAIT_V(8); PG8_WAIT_L(0); PG8_BAR; PG8_MMA(0, 0, At, B0); PG8_MMA(0, 1, At, B1); PG8_BAR; PG8_SCHED;
            PG8_LDA(At, 0, 1); PG8_STAGE(PG8_SB(0, 0), b2, voffB); PG8_STAGE(PG8_SB(0, 1), b2 + hstep, voffB); PG8_STAGE(PG8_SA(0, 0), a2, voffA);
            PG8_WAIT_V(8); PG8_WAIT_L(0); PG8_BAR; PG8_MMA(1, 0, At, B0); PG8_MMA(1, 1, At, B1); PG8_BAR; PG8_SCHED;
            PG8_LDB(B0, 1, 0); PG8_LDB(B1, 1, 1); PG8_SCHED; PG8_LDA(At, 1, 0); PG8_STAGE(PG8_SA(0, 1), a2 + hstep, voffA);
            PG8_WAIT_V(8); PG8_WAIT_L(0); PG8_BAR; PG8_MMA(0, 0, At, B0); PG8_MMA(0, 1, At, B1); PG8_BAR; PG8_SCHED;
            PG8_LDA(At, 1, 1); PG8_STAGE(PG8_SB(1, 0), b3, voffB); PG8_STAGE(PG8_SB(1, 1), b3 + hstep, voffB); PG8_STAGE(PG8_SA(1, 0), a3, voffA);
            PG8_WAIT_V(8); PG8_WAIT_L(0); PG8_BAR; PG8_MMA(1, 0, At, B0); PG8_MMA(1, 1, At, B1); PG8_BAR; PG8_SCHED;
            } else {
            PG8_LDB(B0, 0, 0); PG8_SCHED; PG8_LDA(At, 0, 0); PG8_STAGE(PG8_SA(1, 1), a1 + hstep, voffA);
            PG8_WAIT_L(8); PG8_BAR; PG8_WAIT_L(0); PG8_MMA(0, 0, At, B0); PG8_BAR; PG8_SCHED;
            PG8_LDB(B1, 0, 1); PG8_STAGE(PG8_SB(0, 0), b2, voffB);
            PG8_BAR; PG8_WAIT_L(0); PG8_MMA(0, 1, At, B1); PG8_BAR;
            PG8_LDA(At, 0, 1); PG8_STAGE(PG8_SA(0, 0), a2, voffA);
            PG8_BAR; PG8_WAIT_L(0); PG8_MMA(1, 0, At, B0); PG8_BAR; PG8_SCHED;
            PG8_STAGE(PG8_SB(0, 1), b2 + hstep, voffB);
            PG8_WAIT_V(6); PG8_BAR; PG8_MMA(1, 1, At, B1); PG8_BAR;
            PG8_LDB(B0, 1, 0); PG8_SCHED; PG8_LDA(At, 1, 0); PG8_STAGE(PG8_SA(0, 1), a2 + hstep, voffA);
            PG8_WAIT_L(8); PG8_BAR; PG8_WAIT_L(0); PG8_MMA(0, 0, At, B0); PG8_BAR; PG8_SCHED;
            PG8_LDB(B1, 1, 1); PG8_STAGE(PG8_SB(1, 0), b3, voffB);
            PG8_BAR; PG8_WAIT_L(0); PG8_MMA(0, 1, At, B1); PG8_BAR;
            PG8_LDA(At, 1, 1); PG8_STAGE(PG8_SA(1, 0), a3, voffA);
            PG8_BAR; PG8_WAIT_L(0); PG8_MMA(1, 0, At, B0); PG8_BAR; PG8_SCHED;
            PG8_STAGE(PG8_SB(1, 1), b3 + hstep, voffB);
            PG8_WAIT_V(6); PG8_BAR; PG8_MMA(1, 1, At, B1); PG8_BAR;
            }
        }
        if constexpr (ALIGN_EPI) { if (wr == 0) PG8_BAR; }
        if constexpr (!Epi::AFTER_DRAIN) { E(acc, cur, wr, wc, fr, fq); S.done(cur); }
        if (!has_next) break;
#pragma unroll
        for (int a = 0; a < 2; ++a)
#pragma unroll
            for (int b = 0; b < 2; ++b)
#pragma unroll
                for (int m = 0; m < 4; ++m)
#pragma unroll
                    for (int n = 0; n < 2; ++n) acc[a][b][m][n] = (f32x4){0.f, 0.f, 0.f, 0.f};
        cur = nxt; cA = nA; cB = nB; ++ui;
        if constexpr (ALIGN_EPI) { if (wr == 1) PG8_BAR; }
    }
    PG8_WAIT_V(0);
    if constexpr (!ALIGN_EPI) { if (wr == 0) PG8_BAR; }
    PG8_BAR;
    if constexpr (Epi::AFTER_DRAIN) { E.fused(acc, cur, wr, wc, fr, fq, lds, wid, lane); S.done(cur); }
#undef PG8_SA
#undef PG8_SB
#undef PG8_STAGE
#undef PG8_LDA
#undef PG8_LDB
#undef PG8_MMA
#undef PG8_WAIT_V
#undef PG8_WAIT_L
#undef PG8_BAR
#undef PG8_SCHED
}
}

namespace cg = cooperative_groups;
using pg8::bf16_t; using pg8::bf16x8; using pg8::f32x4; using pg8::u32x4; using pg8::cvt_pk_bf16;
#define LAS __attribute__((address_space(3)))
typedef unsigned u32x2 __attribute__((ext_vector_type(2)));

constexpr int NB = 4, SEQ = 8192, DM = 1024, MTOK = NB * SEQ, NLAYER = 4;
constexpr int RW = 512, RWKV_COLS = 1920, IN_COLS = 3456, NPAD1 = 3584, DFF = 2816;
constexpr size_t MiB = 1u << 20;
constexpr size_t WS_W1 = 0, WS_W2 = 7 * MiB, WS_W3 = 9 * MiB, WS_W4 = 20 * MiB, WS_MOD = 26 * MiB, WS_COEF = 27 * MiB, WS_RSTD = 28 * MiB;
constexpr size_t WS_WL = 25 * MiB + 512 * 1024;
constexpr size_t WS_QKG = 29 * MiB;
constexpr size_t WS_BAR = 29 * MiB + 65536;
constexpr size_t WS_U = 30 * MiB;
constexpr size_t WS_QK = 94 * MiB, WS_VT = 158 * MiB;
constexpr size_t WS_R = 94 * MiB, WS_K = 126 * MiB, WS_V = 158 * MiB;
constexpr size_t WS_ZR = 190 * MiB;
constexpr size_t WS_E0 = 318 * MiB, WS_E1 = 350 * MiB, WS_A0 = 382 * MiB, WS_A1 = 414 * MiB;
constexpr size_t WS_DELTA = 318 * MiB;
constexpr size_t WS_ACT = 94 * MiB;
constexpr size_t WS_END = 446 * MiB;
constexpr int LDS_BYTES = 147456;
constexpr int NPHASE = 1 + 10 * NLAYER;

struct Params { const float* in[24]; float* out; unsigned char* ws; int lo, hi; };
enum { I_X = 0, I_C, I_ADAW, I_ADAB, I_N1G, I_N2G, I_WIN, I_MU, I_W0, I_W2, I_A0, I_A2, I_G2, I_KK, I_KA, I_RK, I_LNG, I_LNB, I_QG, I_KG, I_RPB, I_WOUT, I_FIN, I_FOUT };

__device__ __forceinline__ int fresh_tid();
__device__ __forceinline__ __amdgpu_buffer_rsrc_t ws_rsrc(unsigned char* ws) { return __builtin_amdgcn_make_buffer_rsrc(ws, 0, 0x20000000, 0x00020000); }
__device__ __forceinline__ void st16_wt(__amdgpu_buffer_rsrc_t r, size_t off, u32x4 v) { __builtin_amdgcn_raw_buffer_store_b128(v, r, (int)off, 0, 16); }
__device__ __forceinline__ float bf2f(unsigned short v) { return __builtin_bit_cast(float, (unsigned)v << 16); }
__device__ __forceinline__ float bflo(unsigned w) { return __builtin_bit_cast(float, w << 16); }
__device__ __forceinline__ float bfhi(unsigned w) { return __builtin_bit_cast(float, w & 0xffff0000u); }
__device__ __forceinline__ unsigned short f2bf(float f) { return (unsigned short)(cvt_pk_bf16(f, 0.f) & 0xffffu); }
__device__ __forceinline__ float wave_sum(float v) {
#pragma unroll
    for (int o = 32; o >= 1; o >>= 1) v += __shfl_xor(v, o);
    return v;
}
__device__ __forceinline__ float sigmoidf_(float x) { return __builtin_amdgcn_rcpf(1.f + __expf(-x)); }
template <int CTRL> __device__ __forceinline__ float dppf(float x) { return __builtin_bit_cast(float, __builtin_amdgcn_update_dpp(0, __builtin_bit_cast(int, x), CTRL, 0xF, 0xF, false)); }
__device__ __forceinline__ float rowsum16(float x) { x += dppf<0x128>(x); x += dppf<0x124>(x); x += dppf<0x122>(x); x += dppf<0x121>(x); return x; }

__device__ __forceinline__ void phase_mod(const Params& p, float* lds) {
    const int tid = fresh_tid();
    const float* c = p.in[I_C]; const float* aw = p.in[I_ADAW]; const float* ab = p.in[I_ADAB];
    float* mod = (float*)(p.ws + WS_MOD);
    for (int i = tid; i < NB * DM; i += 512) { const float v = c[i]; lds[i] = v / (1.f + __expf(-v)); }
    __syncthreads();
    float* red = lds + NB * DM;
    const int cl = tid & 63, kp = tid >> 6;
    for (int item = blockIdx.x; item < NLAYER * 96; item += gridDim.x) {
        const int l = item / 96, n = (item % 96) * 64 + cl;
        const float* wp = aw + ((size_t)l * DM + kp * 128) * 6144 + n;
        float a0 = 0.f, a1 = 0.f, a2 = 0.f, a3 = 0.f;
#pragma unroll 8
        for (int k = 0; k < 128; ++k) { const float w = wp[(size_t)k * 6144]; const int kk = kp * 128 + k;
            a0 += w * lds[kk]; a1 += w * lds[DM + kk]; a2 += w * lds[2 * DM + kk]; a3 += w * lds[3 * DM + kk]; }
        red[(kp * 4 + 0) * 64 + cl] = a0; red[(kp * 4 + 1) * 64 + cl] = a1; red[(kp * 4 + 2) * 64 + cl] = a2; red[(kp * 4 + 3) * 64 + cl] = a3;
        __syncthreads();
        if (tid < 256) { const int b = tid >> 6; float s = ab[l * 6144 + n];
#pragma unroll
            for (int q = 0; q < 8; ++q) s += red[(q * 4 + b) * 64 + cl];
            mod[(size_t)(l * NB + b) * 6144 + n] = s; }
        __syncthreads();
    }
}

__device__ __forceinline__ void phase_conv(const Params& p, int l, float* tile) {
    const int tid = fresh_tid();
    constexpr int T1 = (NPAD1 / 64) * 16, T2 = 16 * 16, T3 = (2 * DFF / 64) * 16, T4 = 16 * (DFF / 64);
    for (int it = blockIdx.x; it < T1 + T2 + T3 + T4; it += gridDim.x) {
        int mode, nt, kt, K, Nsrc; const float* src; bf16_t* dst;
        if (it < T1) { mode = 1; nt = it / 16; kt = it % 16; K = DM; Nsrc = IN_COLS; src = p.in[I_WIN] + (size_t)l * DM * IN_COLS; dst = (bf16_t*)(p.ws + WS_W1); }
        else if (it < T1 + T2) { const int i2 = it - T1; mode = 2; nt = i2 / 16; kt = i2 % 16; K = DM; Nsrc = DM; src = p.in[I_WOUT] + (size_t)l * DM * DM; dst = (bf16_t*)(p.ws + WS_W2); }
        else if (it < T1 + T2 + T3) { const int i3 = it - T1 - T2; mode = 3; nt = i3 / 16; kt = i3 % 16; K = DM; Nsrc = 2 * DFF; src = p.in[I_FIN] + (size_t)l * DM * 2 * DFF; dst = (bf16_t*)(p.ws + WS_W3); }
        else { const int i4 = it - T1 - T2 - T3; mode = 4; nt = i4 / 44; kt = i4 % 44; K = DFF; Nsrc = DM; src = p.in[I_FOUT] + (size_t)l * DFF * DM; dst = (bf16_t*)(p.ws + WS_W4); }
        {
            const int nn = tid & 63, kk = tid >> 6, np = nt * 64 + nn; int col;
            if (mode == 1) { const int pn = np >> 8, pp = np & 255, bj = pp >> 7, wc = (pp >> 5) & 3, cc = pp & 31; const int L = 256 * pn + 64 * wc + 32 * bj + cc;
                col = L < 1536 ? RWKV_COLS + L : (L < IN_COLS ? L - 1536 : -1); }
            else if (mode == 3) { const int pn = np >> 8, bj = (np >> 7) & 1, i = np & 127; col = bj * DFF + 128 * pn + i; }
            else col = np;
#pragma unroll
            for (int kr = 0; kr < 8; ++kr) { const int k = kk + 8 * kr; tile[k * 65 + nn] = col >= 0 ? src[(size_t)(kt * 64 + k) * Nsrc + col] : 0.f; }
        }
        __syncthreads();
        {
            const int nn = tid >> 3, kc = tid & 7; u32x4 w;
            w.x = cvt_pk_bf16(tile[(8 * kc + 0) * 65 + nn], tile[(8 * kc + 1) * 65 + nn]); w.y = cvt_pk_bf16(tile[(8 * kc + 2) * 65 + nn], tile[(8 * kc + 3) * 65 + nn]);
            w.z = cvt_pk_bf16(tile[(8 * kc + 4) * 65 + nn], tile[(8 * kc + 5) * 65 + nn]); w.w = cvt_pk_bf16(tile[(8 * kc + 6) * 65 + nn], tile[(8 * kc + 7) * 65 + nn]);
            *(u32x4*)(dst + (size_t)(nt * 64 + nn) * K + kt * 64 + 8 * kc) = w;
        }
        __syncthreads();
    }
    {
        bf16_t* WL = (bf16_t*)(p.ws + WS_WL);
        for (int idx = blockIdx.x * 512 + tid; idx < 512 * 48; idx += gridDim.x * 512) { const int col = idx & 511, kc = idx >> 9, k0 = 8 * kc;
            const float* src;
            if (k0 < 128) src = p.in[I_W2] + ((size_t)(l * 2 + (k0 >> 6)) * 64 + (k0 & 63)) * RW + col;
            else if (k0 < 256) src = p.in[I_A2] + ((size_t)(l * 2 + ((k0 - 128) >> 6)) * 64 + (k0 & 63)) * RW + col;
            else src = p.in[I_G2] + ((size_t)l * 128 + (k0 - 256)) * RW + col;
            u32x4 w; w.x = cvt_pk_bf16(src[0], src[RW]); w.y = cvt_pk_bf16(src[2 * RW], src[3 * RW]); w.z = cvt_pk_bf16(src[4 * RW], src[5 * RW]); w.w = cvt_pk_bf16(src[6 * RW], src[7 * RW]);
            *(u32x4*)(WL + (size_t)col * 384 + k0) = w; }
    }
}

__device__ __forceinline__ void phase_norm(const Params& p, int l, int which, const float* h, float* lds) {
    const int tid = fresh_tid(), lane = tid & 63, wave = tid >> 6;
    const float* mod = (const float*)(p.ws + WS_MOD) + (size_t)l * NB * 6144;
    const float* g = p.in[which == 0 ? I_N1G : I_N2G] + l * DM;
    float* gs = lds; float* sh = lds + NB * DM; float* g1 = lds + 2 * NB * DM;
    const bf16_t* delta = (const bf16_t*)(p.ws + WS_DELTA);
    if (which == 0 && blockIdx.x == 0 && tid < 128) ((float*)(p.ws + WS_QKG))[tid] = tid < 64 ? p.in[I_QG][l * 64 + tid] : p.in[I_KG][l * 64 + tid - 64];
    for (int i = tid; i < NB * DM; i += 512) { const int b = i >> 10, k = i & 1023;
        gs[i] = g[k] * (1.f + mod[b * 6144 + (which * 3 + 1) * DM + k]); sh[i] = mod[b * 6144 + (which * 3) * DM + k]; g1[i] = mod[b * 6144 + 2 * DM + k]; }
    __syncthreads();
    bf16_t* u = (bf16_t*)(p.ws + WS_U);
    const int stride = gridDim.x * 8;
    for (int row0 = blockIdx.x * 8 + wave; row0 < MTOK; row0 += 2 * stride) {
        const int row1 = row0 + stride < MTOK ? row0 + stride : row0;
        const float* hr0 = h + (size_t)row0 * DM; const float* hr1 = h + (size_t)row1 * DM;
        f32x4 v0[4], v1[4]; float ss0 = 0.f, ss1 = 0.f;
#pragma unroll
        for (int q = 0; q < 4; ++q) { v0[q] = *(const f32x4*)(hr0 + 4 * lane + 256 * q); v1[q] = *(const f32x4*)(hr1 + 4 * lane + 256 * q); }
        if (which == 1) {
            const int bb0 = row0 >> 13, bb1 = row1 >> 13;
#pragma unroll
            for (int q = 0; q < 4; ++q) { const int k = 4 * lane + 256 * q;
                const u32x2 d0 = *(const u32x2*)(delta + (size_t)row0 * DM + k), d1 = *(const u32x2*)(delta + (size_t)row1 * DM + k);
                const f32x4 ga = *(const f32x4*)(g1 + bb0 * DM + k), gb = *(const f32x4*)(g1 + bb1 * DM + k);
                v0[q] += ga * (f32x4){bflo(d0.x), bfhi(d0.x), bflo(d0.y), bfhi(d0.y)}; v1[q] += gb * (f32x4){bflo(d1.x), bfhi(d1.x), bflo(d1.y), bfhi(d1.y)}; }
        }
#pragma unroll
        for (int q = 0; q < 4; ++q) { ss0 += v0[q][0] * v0[q][0] + v0[q][1] * v0[q][1] + v0[q][2] * v0[q][2] + v0[q][3] * v0[q][3]; ss1 += v1[q][0] * v1[q][0] + v1[q][1] * v1[q][1] + v1[q][2] * v1[q][2] + v1[q][3] * v1[q][3]; }
        ss0 = wave_sum(ss0); ss1 = wave_sum(ss1);
        const float rstd0 = rsqrtf(ss0 * (1.f / DM) + 1e-6f), rstd1 = rsqrtf(ss1 * (1.f / DM) + 1e-6f);
        const int b0 = row0 >> 13, b1 = row1 >> 13;
#pragma unroll
        for (int q = 0; q < 4; ++q) { const int k = 4 * lane + 256 * q;
            { const f32x4 gg = *(const f32x4*)(gs + b0 * DM + k), ss4 = *(const f32x4*)(sh + b0 * DM + k);
              const f32x4 o = v0[q] * rstd0 * gg + ss4; u32x2 w; w.x = cvt_pk_bf16(o[0], o[1]); w.y = cvt_pk_bf16(o[2], o[3]); *(u32x2*)(u + (size_t)row0 * DM + k) = w; }
            { const f32x4 gg = *(const f32x4*)(gs + b1 * DM + k), ss4 = *(const f32x4*)(sh + b1 * DM + k);
              const f32x4 o = v1[q] * rstd1 * gg + ss4; u32x2 w; w.x = cvt_pk_bf16(o[0], o[1]); w.y = cvt_pk_bf16(o[2], o[3]); *(u32x2*)(u + (size_t)row1 * DM + k) = w; }
        }
    }
}

struct EpiZ {
    static constexpr bool PERM = true, AFTER_DRAIN = false;
    unsigned char* ws;
    __device__ __forceinline__ void operator()(const f32x4 (&acc)[2][2][4][2], const pg8::Unit& u, int wr, int wc, int fr, int fq) const {
        const int pn = u.pn, row0 = u.pm * 256 + wr * 64 + fr;
        bf16_t* qk = (bf16_t*)(ws + WS_QK); bf16_t* vT = (bf16_t*)(ws + WS_VT); bf16_t* zr = (bf16_t*)(ws + WS_ZR);
        const __amdgpu_buffer_rsrc_t rs = ws_rsrc(ws);
        if (pn < 4) {
            const float* gg = (const float*)(ws + WS_QKG) + (pn < 2 ? 0 : 64); const float sc = pn < 2 ? 0.125f : 1.f;
            f32x4 gv[2][2];
#pragma unroll
            for (int bj = 0; bj < 2; ++bj)
#pragma unroll
                for (int n = 0; n < 2; ++n) gv[bj][n] = *(const f32x4*)(gg + 32 * bj + 8 * fq + 4 * n) * sc;
            asm volatile("s_waitcnt vmcnt(0)" ::: "memory");
#pragma unroll
            for (int ai = 0; ai < 2; ++ai)
#pragma unroll
                for (int m = 0; m < 4; ++m) {
                    float ss = 0.f;
#pragma unroll
                    for (int bj = 0; bj < 2; ++bj)
#pragma unroll
                        for (int n = 0; n < 2; ++n) { const f32x4 a = acc[ai][bj][m][n]; ss += a[0] * a[0] + a[1] * a[1] + a[2] * a[2] + a[3] * a[3]; }
                    ss += __shfl_xor(ss, 16); ss += __shfl_xor(ss, 32);
                    const float rstd = rsqrtf(ss * (1.f / 64.f) + 1e-6f);
                    bf16_t* rowp = qk + (size_t)(row0 + ai * 128 + m * 16) * 1024 + pn * 256 + 64 * wc + 8 * fq;
#pragma unroll
                    for (int bj = 0; bj < 2; ++bj) { const f32x4 v0 = acc[ai][bj][m][0] * rstd * gv[bj][0], v1 = acc[ai][bj][m][1] * rstd * gv[bj][1];
                        u32x4 w; w.x = cvt_pk_bf16(v0[0], v0[1]); w.y = cvt_pk_bf16(v0[2], v0[3]); w.z = cvt_pk_bf16(v1[0], v1[1]); w.w = cvt_pk_bf16(v1[2], v1[3]);
                        st16_wt(rs, (size_t)((const unsigned char*)(rowp + 32 * bj) - ws), w); }
                }
        } else if (pn < 6) {
            const int h = (pn - 4) * 4 + wc;
#pragma unroll
            for (int ai = 0; ai < 2; ++ai)
#pragma unroll
                for (int m = 0; m < 4; ++m) { const int row = row0 + ai * 128 + m * 16, b = row >> 13, t = row & 8191;
                    bf16_t* base = vT + ((size_t)(b * 8 + h) * 64 + 8 * fq) * SEQ + t;
#pragma unroll
                    for (int bj = 0; bj < 2; ++bj)
#pragma unroll
                        for (int n = 0; n < 2; ++n)
#pragma unroll
                            for (int j = 0; j < 4; ++j) base[(size_t)(32 * bj + 4 * n + j) * SEQ] = f2bf(acc[ai][bj][m][n][j]);
                }
        } else {
            const int colbase = (pn - 6) * 256 + 64 * wc + 8 * fq;
#pragma unroll
            for (int ai = 0; ai < 2; ++ai)
#pragma unroll
                for (int m = 0; m < 4; ++m) { bf16_t* rowp = zr + (size_t)(row0 + ai * 128 + m * 16) * 2048 + colbase;
#pragma unroll
                    for (int bj = 0; bj < 2; ++bj) { const f32x4 v0 = acc[ai][bj][m][0], v1 = acc[ai][bj][m][1];
                        u32x4 w; w.x = cvt_pk_bf16(v0[0], v0[1]); w.y = cvt_pk_bf16(v0[2], v0[3]); w.z = cvt_pk_bf16(v1[0], v1[1]); w.w = cvt_pk_bf16(v1[2], v1[3]);
                        st16_wt(rs, (size_t)((const unsigned char*)(rowp + 32 * bj) - ws), w); }
                }
        }
    }
};

struct EpiRes {
    static constexpr bool PERM = true, AFTER_DRAIN = false;
    const float* hin; float* hout; unsigned char* ws; int gate_off; int gate1_off;
    __device__ __forceinline__ void operator()(const f32x4 (&acc)[2][2][4][2], const pg8::Unit& u, int wr, int wc, int fr, int fq) const {
        const int row0 = u.pm * 256 + wr * 64 + fr, col0 = u.pn * 256 + wc * 32 + 8 * fq, b = (u.pm * 256) >> 13;
        const float* gate = (const float*)(ws + WS_MOD) + gate_off;
        const float* gate1 = (const float*)(ws + WS_MOD) + (gate1_off < 0 ? 0 : gate1_off);
        const bf16_t* delta = (const bf16_t*)(ws + WS_DELTA);
        f32x4 gv[2][2], g1[2][2];
#pragma unroll
        for (int bj = 0; bj < 2; ++bj)
#pragma unroll
            for (int n = 0; n < 2; ++n) { gv[bj][n] = *(const f32x4*)(gate + b * 6144 + col0 + 128 * bj + 4 * n); g1[bj][n] = *(const f32x4*)(gate1 + b * 6144 + col0 + 128 * bj + 4 * n); }
#pragma unroll
        for (int ai = 0; ai < 2; ++ai)
#pragma unroll
            for (int m = 0; m < 4; ++m) { const size_t ro = (size_t)(row0 + ai * 128 + m * 16) * DM + col0;
#pragma unroll
                for (int bj = 0; bj < 2; ++bj) {
                    f32x4 h0 = *(const f32x4*)(hin + ro + 128 * bj), h1 = *(const f32x4*)(hin + ro + 128 * bj + 4);
                    if (gate1_off >= 0) { const u32x4 dw = *(const u32x4*)(delta + ro + 128 * bj);
                        h0 += g1[bj][0] * (f32x4){bflo(dw.x), bfhi(dw.x), bflo(dw.y), bfhi(dw.y)}; h1 += g1[bj][1] * (f32x4){bflo(dw.z), bfhi(dw.z), bflo(dw.w), bfhi(dw.w)}; }
                    *(f32x4*)(hout + ro + 128 * bj) = h0 + gv[bj][0] * acc[ai][bj][m][0];
                    *(f32x4*)(hout + ro + 128 * bj + 4) = h1 + gv[bj][1] * acc[ai][bj][m][1]; }
            }
    }
};

struct EpiDelta {
    static constexpr bool PERM = true, AFTER_DRAIN = false;
    unsigned char* ws;
    __device__ __forceinline__ void operator()(const f32x4 (&acc)[2][2][4][2], const pg8::Unit& u, int wr, int wc, int fr, int fq) const {
        const int row0 = u.pm * 256 + wr * 64 + fr, col0 = u.pn * 256 + wc * 32 + 8 * fq; bf16_t* delta = (bf16_t*)(ws + WS_DELTA);
        const __amdgpu_buffer_rsrc_t rs = ws_rsrc(ws);
#pragma unroll
        for (int ai = 0; ai < 2; ++ai)
#pragma unroll
            for (int m = 0; m < 4; ++m) { bf16_t* rowp = delta + (size_t)(row0 + ai * 128 + m * 16) * DM + col0;
#pragma unroll
                for (int bj = 0; bj < 2; ++bj) { const f32x4 v0 = acc[ai][bj][m][0], v1 = acc[ai][bj][m][1];
                    u32x4 w; w.x = cvt_pk_bf16(v0[0], v0[1]); w.y = cvt_pk_bf16(v0[2], v0[3]); w.z = cvt_pk_bf16(v1[0], v1[1]); w.w = cvt_pk_bf16(v1[2], v1[3]);
                    st16_wt(rs, (size_t)((const unsigned char*)(rowp + 128 * bj) - ws), w); }
            }
    }
};

struct EpiSwiglu {
    static constexpr bool PERM = true, AFTER_DRAIN = false;
    unsigned char* ws;
    __device__ __forceinline__ void operator()(const f32x4 (&acc)[2][2][4][2], const pg8::Unit& u, int wr, int wc, int fr, int fq) const {
        const int row0 = u.pm * 256 + wr * 64 + fr, col0 = u.pn * 128 + wc * 32 + 8 * fq; const __amdgpu_buffer_rsrc_t rs = ws_rsrc(ws);
#pragma unroll
        for (int ai = 0; ai < 2; ++ai)
#pragma unroll
            for (int m = 0; m < 4; ++m) { float o[8];
#pragma unroll
                for (int n = 0; n < 2; ++n)
#pragma unroll
                    for (int j = 0; j < 4; ++j) { const float gte = acc[ai][0][m][n][j], up = acc[ai][1][m][n][j]; o[4 * n + j] = gte * __builtin_amdgcn_rcpf(1.f + __expf(-gte)) * up; }
                u32x4 w; w.x = cvt_pk_bf16(o[0], o[1]); w.y = cvt_pk_bf16(o[2], o[3]); w.z = cvt_pk_bf16(o[4], o[5]); w.w = cvt_pk_bf16(o[6], o[7]);
                st16_wt(rs, WS_ACT + ((size_t)(row0 + ai * 128 + m * 16) * DFF + col0) * 2, w); }
    }
};

struct EpiAny {
    static constexpr bool PERM = true, AFTER_DRAIN = false;
    int mode; unsigned char* ws; const float* hin; float* hout; int gate_off; int gate1_off;
    __device__ __forceinline__ void operator()(const f32x4 (&acc)[2][2][4][2], const pg8::Unit& u, int wr, int wc, int fr, int fq) const {
        if (mode == 0) { EpiZ E{ws}; E(acc, u, wr, wc, fr, fq); }
        else if (mode == 1) { EpiRes E{hin, hout, ws, gate_off, gate1_off}; E(acc, u, wr, wc, fr, fq); }
        else if (mode == 3) { EpiDelta E{ws}; E(acc, u, wr, wc, fr, fq); }
        else { EpiSwiglu E{ws}; E(acc, u, wr, wc, fr, fq); }
    }
};

__device__ __forceinline__ void phase_attn(const Params& p, int l, float* lds) {
    const int tid = fresh_tid(), lane = tid & 63, wave = tid >> 6, fr = lane & 15, fq = lane >> 4;
    const float* rpb = p.in[I_RPB] + (size_t)l * 8 * 15 * 31;
    for (int i = tid; i < 8 * 15 * 31; i += 512) lds[i] = rpb[i];
    __syncthreads();
    const bf16_t* qk = (const bf16_t*)(p.ws + WS_QK); const bf16_t* vT = (const bf16_t*)(p.ws + WS_VT); bf16_t* ymix = (bf16_t*)(p.ws + WS_U);
    for (int task = blockIdx.x * 8 + wave; task < NB * 128 * 8 * 4; task += gridDim.x * 8) {
        const int g = task & 3, h = (task >> 2) & 7, i = (task >> 5) & 127, b = task >> 12;
        const int r0 = min(max(i - 4, 0), 120), c0 = g == 0 ? 0 : (g == 1 ? 8 : (g == 2 ? 24 : 32));
        const int qcol = 16 * g + fr, cs = min(max(qcol - 8, 0), 48);
        const size_t qtok = (size_t)b * SEQ + i * 64 + qcol;
        bf16x8 qf[2];
        qf[0] = *(const bf16x8*)(qk + qtok * 1024 + h * 64 + 8 * fq); qf[1] = *(const bf16x8*)(qk + qtok * 1024 + h * 64 + 32 + 8 * fq);
        const int kcolA = c0 + 8 * (fr >> 2) + (fr & 3);
        const bf16_t* kbase = qk + ((size_t)b * SEQ + r0 * 64 + kcolA) * 1024 + 512 + h * 64 + 8 * fq;
        const bf16_t* vbase = vT + ((size_t)(b * 8 + h) * 64 + fr) * SEQ + r0 * 64 + c0 + 8 * fq;
        bf16x8 kf[8][2][2];
#pragma unroll
        for (int kr = 0; kr < 8; ++kr)
#pragma unroll
            for (int blk = 0; blk < 2; ++blk) { const bf16_t* kp = kbase + (size_t)(kr * 64 + 4 * blk) * 1024; kf[kr][blk][0] = *(const bf16x8*)kp; kf[kr][blk][1] = *(const bf16x8*)(kp + 32); }
        __builtin_amdgcn_sched_barrier(0);
        float sc[8][8];
#pragma unroll
        for (int kr = 0; kr < 8; ++kr)
#pragma unroll
            for (int blk = 0; blk < 2; ++blk) {
                f32x4 a = {0.f, 0.f, 0.f, 0.f};
                a = __builtin_amdgcn_mfma_f32_16x16x32_bf16(kf[kr][blk][0], qf[0], a, 0, 0, 0);
                a = __builtin_amdgcn_mfma_f32_16x16x32_bf16(kf[kr][blk][1], qf[1], a, 0, 0, 0);
#pragma unroll
                for (int j = 0; j < 4; ++j) sc[kr][4 * blk + j] = a[j];
            }
        __builtin_amdgcn_sched_barrier(0);
        bf16x8 vfa[2][8];
#pragma unroll
        for (int db = 0; db < 2; ++db)
#pragma unroll
            for (int kr = 0; kr < 8; ++kr) vfa[db][kr] = *(const bf16x8*)(vbase + (size_t)(16 * db) * SEQ + kr * 64);
        __builtin_amdgcn_sched_barrier(0);
        float mx = -1e30f;
#pragma unroll
        for (int kr = 0; kr < 8; ++kr) { const int ro = r0 + kr - i + 7;
#pragma unroll
            for (int e = 0; e < 8; ++e) { const int kc = c0 + 8 * fq + e; const bool valid = (kc >= cs) && (kc < cs + 16); const int co = min(max(kc - qcol + 15, 0), 30);
                const float s = valid ? sc[kr][e] + lds[(h * 15 + ro) * 31 + co] : -1e30f; sc[kr][e] = s; mx = fmaxf(mx, s); } }
        mx = fmaxf(mx, __shfl_xor(mx, 16)); mx = fmaxf(mx, __shfl_xor(mx, 32));
        float sum = 0.f; bf16x8 pf[8];
#pragma unroll
        for (int kr = 0; kr < 8; ++kr) { float pe[8];
#pragma unroll
            for (int e = 0; e < 8; ++e) { pe[e] = __builtin_amdgcn_exp2f((sc[kr][e] - mx) * 1.4426950408889634f); sum += pe[e]; }
            u32x4 w; w.x = cvt_pk_bf16(pe[0], pe[1]); w.y = cvt_pk_bf16(pe[2], pe[3]); w.z = cvt_pk_bf16(pe[4], pe[5]); w.w = cvt_pk_bf16(pe[6], pe[7]);
            pf[kr] = __builtin_bit_cast(bf16x8, w); }
        sum += __shfl_xor(sum, 16); sum += __shfl_xor(sum, 32);
        const float inv = 1.f / sum;
        __builtin_amdgcn_sched_barrier(0);
        bf16x8 vfb[2][8];
#pragma unroll
        for (int db = 0; db < 2; ++db)
#pragma unroll
            for (int kr = 0; kr < 8; ++kr) vfb[db][kr] = *(const bf16x8*)(vbase + (size_t)(16 * (db + 2)) * SEQ + kr * 64);
        __builtin_amdgcn_sched_barrier(0);
        f32x4 o[4];
#pragma unroll
        for (int db = 0; db < 4; ++db) { o[db] = (f32x4){0.f, 0.f, 0.f, 0.f};
#pragma unroll
            for (int kr = 0; kr < 8; ++kr) o[db] = __builtin_amdgcn_mfma_f32_16x16x32_bf16(db < 2 ? vfa[db & 1][kr] : vfb[db & 1][kr], pf[kr], o[db], 0, 0, 0); }
        asm volatile("s_waitcnt vmcnt(0)" ::: "memory");
#pragma unroll
        for (int db = 0; db < 4; ++db) { u32x2 w; w.x = cvt_pk_bf16(o[db][0] * inv, o[db][1] * inv); w.y = cvt_pk_bf16(o[db][2] * inv, o[db][3] * inv);
            *(u32x2*)(ymix + qtok * 1024 + 512 + h * 64 + 16 * db + 4 * fq) = w; }
    }
}

constexpr int PT = 32, PSTR = 392;
constexpr int PC_OFF = 6400;
__device__ __forceinline__ float fast_tanh(float x) { return 1.f - 2.f * __builtin_amdgcn_rcpf(1.f + __expf(2.f * x)); }
__device__ __forceinline__ void phase_prep(const Params& p, int l, float* ldsf) {
    const int tid = fresh_tid(), wave = __builtin_amdgcn_readfirstlane(tid >> 6);
    bf16_t* lact = (bf16_t*)ldsf;
    float* cmu0 = ldsf + PC_OFF; float* cmu1 = cmu0 + 1920; float* ckk = cmu1 + 1920; float* cka = ckk + 512; float* crk = cka + 512; float* cw0 = crk + 512; float* ca0 = cw0 + 1024;
    const bf16_t* zr = (const bf16_t*)(p.ws + WS_ZR); const bf16_t* WL = (const bf16_t*)(p.ws + WS_WL);
    bf16_t* R = (bf16_t*)(p.ws + WS_R); bf16_t* K = (bf16_t*)(p.ws + WS_K); bf16_t* V = (bf16_t*)(p.ws + WS_V);
    bf16_t* ymix = (bf16_t*)(p.ws + WS_U); float* coef = (float*)(p.ws + WS_COEF); float* rstdp = (float*)(p.ws + WS_RSTD);
    for (int i = tid; i < 3840; i += 512) cmu0[i] = p.in[I_MU][(size_t)l * 3840 + i];
    for (int i = tid; i < 512; i += 512) { ckk[i] = p.in[I_KK][l * RW + i]; cka[i] = p.in[I_KA][l * RW + i]; crk[i] = p.in[I_RK][l * RW + i]; }
    for (int i = tid; i < 1024; i += 512) { cw0[i] = p.in[I_W0][l * 1024 + i]; ca0[i] = p.in[I_A0][l * 1024 + i]; }
    __syncthreads();
    unsigned zc1[12], zp1[12], zn1[12];
#define PREP_S1_LOAD(TILE) do { int t_ = tid; asm volatile("" : "+v"(t_)); \
        _Pragma("unroll") for (int i = 0; i < 12; ++i) { const int idx = t_ + 512 * i, tt = idx / 192, c2 = idx - tt * 192; \
            const bf16_t* zc_p = zr + (size_t)((TILE) * PT + tt) * 2048 + 1536 + 2 * c2; \
            zc1[i] = *(const unsigned*)(zc_p); zp1[i] = *(const unsigned*)(zc_p - 2048); zn1[i] = *(const unsigned*)(zc_p + 2048); } } while (0)
    if ((int)blockIdx.x < MTOK / PT) PREP_S1_LOAD(blockIdx.x);
    for (int tile = blockIdx.x; tile < MTOK / PT; tile += gridDim.x) {
        const int m0 = tile * PT;
        int lane = tid & 63; asm volatile("" : "+v"(lane));
        const int fr = lane & 15, fq = lane >> 4;
        asm volatile("s_waitcnt vmcnt(0)" ::: "memory");
        { int t_ = tid; asm volatile("" : "+v"(t_));
#pragma unroll
        for (int i = 0; i < 12; ++i) { const int idx = t_ + 512 * i, tt = idx / 192, c2 = idx - tt * 192, m = m0 + tt, t = m & 8191, col = 1536 + 2 * c2;
            const unsigned zc = zc1[i], zp = zp1[i], zn = zn1[i];
            const float pmask = t == 0 ? 0.f : 1.f, nmask = t == SEQ - 1 ? 0.f : 1.f;
            const float2 m0v = *(const float2*)(cmu0 + col), m1v = *(const float2*)(cmu1 + col);
            float v0 = bflo(zc) + m0v.x * (bflo(zp) * pmask - bflo(zc)) + m1v.x * (bflo(zn) * nmask - bflo(zc));
            float v1 = bfhi(zc) + m0v.y * (bfhi(zp) * pmask - bfhi(zc)) + m1v.y * (bfhi(zn) * nmask - bfhi(zc));
            if (c2 < 64) { v0 = fast_tanh(v0); v1 = fast_tanh(v1); } else if (c2 >= 128) { v0 = sigmoidf_(v0); v1 = sigmoidf_(v1); }
            *(unsigned*)(lact + tt * PSTR + 2 * c2) = cvt_pk_bf16(v0, v1); } }
        if (tile + (int)gridDim.x < MTOK / PT) PREP_S1_LOAD(tile + gridDim.x);
        __syncthreads();
        f32x4 asum[2][4];
        const bf16_t* wlb = WL + (size_t)(64 * wave + 8 * (fr >> 2) + (fr & 3)) * 384 + 8 * fq;
#pragma unroll
        for (int o = 0; o < 5; ++o) {
            f32x4 acc[2][4];
#pragma unroll
            for (int mb = 0; mb < 2; ++mb)
#pragma unroll
                for (int nb = 0; nb < 4; ++nb) acc[mb][nb] = (f32x4){0.f, 0.f, 0.f, 0.f};
            const int ks0 = o < 4 ? 2 * o : 8;
            bf16x8 wf[4][4];
#pragma unroll
            for (int kk = 0; kk < 4; ++kk)
#pragma unroll
                for (int nb = 0; nb < 4; ++nb) if (kk < (o < 4 ? 2 : 4)) wf[kk][nb] = *(const bf16x8*)(wlb + (size_t)(32 * (nb >> 1) + 4 * (nb & 1)) * 384 + 32 * (ks0 + kk));
            __builtin_amdgcn_sched_barrier(0);
            asm volatile("s_waitcnt vmcnt(0)" ::: "memory");
#pragma unroll
            for (int kk = 0; kk < 4; ++kk) if (kk < (o < 4 ? 2 : 4)) { const int ks = ks0 + kk;
                bf16x8 af[2];
#pragma unroll
                for (int mb = 0; mb < 2; ++mb) af[mb] = *(const bf16x8*)(lact + (16 * mb + fr) * PSTR + 32 * ks + 8 * fq);
#pragma unroll
                for (int mb = 0; mb < 2; ++mb)
#pragma unroll
                    for (int nb = 0; nb < 4; ++nb) acc[mb][nb] = __builtin_amdgcn_mfma_f32_16x16x32_bf16(wf[kk][nb], af[mb], acc[mb][nb], 0, 0, 0);
            }
#pragma unroll
            for (int np = 0; np < 2; ++np) { const int col = 64 * wave + 32 * np + 8 * fq;
                f32x4 bias0 = {0.f, 0.f, 0.f, 0.f}, bias1 = {0.f, 0.f, 0.f, 0.f};
                if (o < 2) { bias0 = *(const f32x4*)(cw0 + o * RW + col); bias1 = *(const f32x4*)(cw0 + o * RW + col + 4); }
                else if (o < 4) { bias0 = *(const f32x4*)(ca0 + (o - 2) * RW + col); bias1 = *(const f32x4*)(ca0 + (o - 2) * RW + col + 4); }
#pragma unroll
                for (int mb = 0; mb < 2; ++mb) { const size_t m = (size_t)(m0 + 16 * mb + fr); f32x4 v0 = acc[mb][2 * np] + bias0, v1 = acc[mb][2 * np + 1] + bias1;
                    if (o < 4) {
#pragma unroll
                        for (int j = 0; j < 4; ++j) { v0[j] = sigmoidf_(v0[j]); v1[j] = sigmoidf_(v1[j]); }
                        if (o < 2) { v0 = v0 * 0.6065306597126334f; v1 = v1 * 0.6065306597126334f; }
                        else if (o == 2) { asum[mb][2 * np] = v0; asum[mb][2 * np + 1] = v1; } else { asum[mb][2 * np] += v0; asum[mb][2 * np + 1] += v1; } }
                    u32x4 w; w.x = cvt_pk_bf16(v0[0], v0[1]); w.y = cvt_pk_bf16(v0[2], v0[3]); w.z = cvt_pk_bf16(v1[0], v1[1]); w.w = cvt_pk_bf16(v1[2], v1[3]);
                    bf16_t* dst = o == 4 ? ymix + m * 1024 + col : (bf16_t*)(p.ws + (o == 0 ? WS_E0 : (o == 1 ? WS_E1 : (o == 2 ? WS_A0 : WS_A1)))) + m * RW + col;
                    *(u32x4*)dst = w; }
            }
            __builtin_amdgcn_sched_barrier(0);
        }
#pragma unroll
        for (int mb = 0; mb < 2; ++mb) { const int m = m0 + 16 * mb + fr, t = m & 8191; float ssq = 0.f, cf = 0.f;
            const int lc = 64 * wave + 8 * fq;
            const bf16_t* zc_p = zr + (size_t)m * 2048 + lc; const bf16_t* zp_p = zc_p - 2048; const bf16_t* zn_p = zc_p + 2048;
            const float pmask = t == 0 ? 0.f : 1.f, nmask = t == SEQ - 1 ? 0.f : 1.f;
            bf16_t* Rp = R + (size_t)m * RW + lc; bf16_t* Kp = K + (size_t)m * RW + lc; bf16_t* Vp = V + (size_t)m * RW + lc;
            u32x4 zcv[2][3], zpv[2][3], znv[2][3];
#pragma unroll
            for (int np = 0; np < 2; ++np)
#pragma unroll
                for (int part = 0; part < 3; ++part) { const int co = part * 512 + 32 * np; zcv[np][part] = *(const u32x4*)(zc_p + co); zpv[np][part] = *(const u32x4*)(zp_p + co); znv[np][part] = *(const u32x4*)(zn_p + co); }
            __builtin_amdgcn_sched_barrier(0);
            asm volatile("s_waitcnt vmcnt(0)" ::: "memory");
#pragma unroll
            for (int np = 0; np < 2; ++np) { float rr[8], kx[8];
#pragma unroll
                for (int part = 0; part < 3; ++part) { const int co = part * 512 + 32 * np;
                    const u32x4 zc = zcv[np][part], zp = zpv[np][part], zn = znv[np][part];
                    float o8[8];
#pragma unroll
                    for (int hf = 0; hf < 2; ++hf) { const f32x4 m0v = *(const f32x4*)(cmu0 + lc + co + 4 * hf), m1v = *(const f32x4*)(cmu1 + lc + co + 4 * hf);
                        const unsigned c0_ = hf ? zc.z : zc.x, c1_ = hf ? zc.w : zc.y, p0_ = hf ? zp.z : zp.x, p1_ = hf ? zp.w : zp.y, n0_ = hf ? zn.z : zn.x, n1_ = hf ? zn.w : zn.y;
                        float c4[4] = {bflo(c0_), bfhi(c0_), bflo(c1_), bfhi(c1_)}, p4[4] = {bflo(p0_), bfhi(p0_), bflo(p1_), bfhi(p1_)}, n4[4] = {bflo(n0_), bfhi(n0_), bflo(n1_), bfhi(n1_)};
#pragma unroll
                        for (int j = 0; j < 4; ++j) o8[4 * hf + j] = c4[j] + m0v[j] * (p4[j] * pmask - c4[j]) + m1v[j] * (n4[j] * nmask - c4[j]); }
                    u32x4 w; w.x = cvt_pk_bf16(o8[0], o8[1]); w.y = cvt_pk_bf16(o8[2], o8[3]); w.z = cvt_pk_bf16(o8[4], o8[5]); w.w = cvt_pk_bf16(o8[6], o8[7]);
                    *(u32x4*)((part == 0 ? Rp : (part == 1 ? Kp : Vp)) + 32 * np) = w;
                    if (part == 0) {
#pragma unroll
                        for (int e = 0; e < 8; ++e) rr[e] = o8[e]; }
                    if (part == 1) {
#pragma unroll
                        for (int e = 0; e < 8; ++e) kx[e] = o8[e]; }
                }
#pragma unroll
                for (int hf = 0; hf < 2; ++hf) { const f32x4 kk4 = *(const f32x4*)(ckk + lc + 32 * np + 4 * hf), ka4 = *(const f32x4*)(cka + lc + 32 * np + 4 * hf), rk4 = *(const f32x4*)(crk + lc + 32 * np + 4 * hf);
#pragma unroll
                    for (int j = 0; j < 4; ++j) { const float kq = kx[4 * hf + j] * kk4[j]; ssq += kq * kq; cf += rr[4 * hf + j] * kx[4 * hf + j] * (2.f + (asum[mb][2 * np + hf][j] - 2.f) * ka4[j]) * rk4[j]; } }
            }
            ssq += __shfl_xor(ssq, 16); ssq += __shfl_xor(ssq, 32); cf += __shfl_xor(cf, 16); cf += __shfl_xor(cf, 32);
            if (fq == 0) { rstdp[(size_t)m * 8 + wave] = 1.f / fmaxf(sqrtf(ssq), 1e-12f); coef[(size_t)m * 8 + wave] = cf; }
            __builtin_amdgcn_sched_barrier(0);
        }
        __syncthreads();
    }
}

constexpr int ST = 32, SSTR = 336;
constexpr int YP_OFF = 2 * ST * SSTR;
typedef float f32x2_t __attribute__((ext_vector_type(2)));
#define SCAN_LOAD(CH, RW_, KW_, EW_, AW_, RS_, VW_) do { \
    _Pragma("unroll") for (int i = 0; i < 4; ++i) { const int tt = sg + 8 * i, s_ = (CH) * ST + tt, t_ = d ? SEQ - 1 - s_ : s_; const size_t m_ = (size_t)b * SEQ + t_; \
        RW_[i] = *(const unsigned*)(R + m_ * RW + h * 64 + 2 * j2); KW_[i] = *(const unsigned*)(K + m_ * RW + h * 64 + 2 * j2); \
        EW_[i] = *(const unsigned*)(E + m_ * RW + h * 64 + 2 * j2); AW_[i] = *(const unsigned*)(A + m_ * RW + h * 64 + 2 * j2); RS_[i] = rstdp[m_ * 8 + h]; } \
    { const int s_ = (CH) * ST + tv, t_ = d ? SEQ - 1 - s_ : s_; const size_t m_ = (size_t)b * SEQ + t_; VW_ = *(const unsigned*)(V + m_ * RW + h * 64 + 16 * rg + 2 * vi2); } } while (0)
__device__ __forceinline__ void phase_scan(const Params& p, int l, float* lds) {
    const int tid = fresh_tid(), lane = tid & 63, wave = tid >> 6;
    const bf16_t* R = (const bf16_t*)(p.ws + WS_R); const bf16_t* K = (const bf16_t*)(p.ws + WS_K); const bf16_t* V = (const bf16_t*)(p.ws + WS_V);
    const float* rstdp = (const float*)(p.ws + WS_RSTD);
    constexpr int NCH = SEQ / ST;
    for (int item = blockIdx.x; item < 256; item += gridDim.x) {
        const int chain = (item & 7) + 8 * (item >> 5), rg = (item >> 3) & 3, d = chain >> 5, b = (chain >> 3) & 3, h = chain & 7;
        const bf16_t* E = (const bf16_t*)(p.ws + (d ? WS_E1 : WS_E0)); const bf16_t* A = (const bf16_t*)(p.ws + (d ? WS_A1 : WS_A0));
        float* ydir = (float*)(p.ws + WS_ZR) + (size_t)d * MTOK * RW;
        if (wave >= 4) {
            const int lt = tid - 256, j2 = lt & 31, sg = lt >> 5, tv = lt >> 3, vi2 = lt & 7;
            const float kk0 = p.in[I_KK][l * RW + h * 64 + 2 * j2], kk1 = p.in[I_KK][l * RW + h * 64 + 2 * j2 + 1];
            const float ka0 = p.in[I_KA][l * RW + h * 64 + 2 * j2], ka1 = p.in[I_KA][l * RW + h * 64 + 2 * j2 + 1];
            unsigned rwA[4], kwA[4], ewA[4], awA[4], vwA; float rsA[4];
            SCAN_LOAD(0, rwA, kwA, ewA, awA, rsA, vwA);
            for (int ch = 0; ch < NCH + 2; ++ch) {
                asm volatile("s_waitcnt vmcnt(0)" ::: "memory");
                if (ch < NCH) {
                    float* buf = lds + (ch & 1) * ST * SSTR;
#pragma unroll
                    for (int i = 0; i < 4; ++i) { const int tt = sg + 8 * i;
                        const float k0 = bflo(kwA[i]), k1 = bfhi(kwA[i]), a0 = bflo(awA[i]), a1 = bfhi(awA[i]);
                        const float q0 = k0 * kk0 * rsA[i], q1 = k1 * kk1 * rsA[i];
                        float* bp = buf + tt * SSTR + 2 * j2;
                        *(float2*)(bp) = make_float2(__expf(-bflo(ewA[i])), __expf(-bfhi(ewA[i])));
                        *(float2*)(bp + 64) = make_float2(k0 * (1.f + (a0 - 1.f) * ka0), k1 * (1.f + (a1 - 1.f) * ka1));
                        *(float2*)(bp + 128) = make_float2(q0 * a0, q1 * a1);
                        *(float2*)(bp + 192) = make_float2(q0, q1);
                        *(float2*)(bp + 256) = make_float2(bflo(rwA[i]), bfhi(rwA[i])); }
                    *(float2*)(buf + tv * SSTR + 320 + 2 * vi2) = make_float2(bflo(vwA), bfhi(vwA));
                }
                if (ch >= 2) {
                    const float* yp = lds + YP_OFF + (((ch & 1) * ST + tv) * 16 + 2 * vi2) * 8;
                    const int rot = (lt >> 2) & 3; float ya = 0.f, yb = 0.f;
#pragma unroll
                    for (int e = 0; e < 4; ++e) { const int c = (e + rot) & 3; const f32x4 pv = *(const f32x4*)(yp + 4 * c); const float sv = (pv[0] + pv[1]) + (pv[2] + pv[3]);
                        ya += c < 2 ? sv : 0.f; yb += c < 2 ? 0.f : sv; }
                    const int s_ = (ch - 2) * ST + tv, t_ = d ? SEQ - 1 - s_ : s_;
                    *(float2*)(ydir + ((size_t)b * SEQ + t_) * RW + h * 64 + 16 * rg + 2 * vi2) = make_float2(ya, yb);
                }
                if (ch + 1 < NCH) SCAN_LOAD(ch + 1, rwA, kwA, ewA, awA, rsA, vwA);
                __syncthreads();
            }
        } else {
            const int cgp = lane >> 4, q = lane & 15;
            f32x2_t s01 = {0.f, 0.f}, s23 = {0.f, 0.f};
            for (int ch = 0; ch < NCH + 2; ++ch) {
                if (ch >= 1 && ch <= NCH) {
                    const float* buf = lds + ((ch - 1) & 1) * ST * SSTR;
                    float* ypw = lds + YP_OFF + ((((ch - 1) & 1) * ST) * 16 + 4 * wave + cgp) * 8 + (q & 7);
                    const float* bq = buf + 4 * q; const float* bvp = buf + 320 + 4 * wave + cgp;
                    f32x4 w4 = *(const f32x4*)(bq), kd = *(const f32x4*)(bq + 64), bv = *(const f32x4*)(bq + 128), kk = *(const f32x4*)(bq + 192), r4 = *(const f32x4*)(bq + 256);
                    float vv = bvp[0];
                    f32x4 w4n = *(const f32x4*)(bq + SSTR), kdn = *(const f32x4*)(bq + SSTR + 64), bvn = *(const f32x4*)(bq + SSTR + 128), kkn = *(const f32x4*)(bq + SSTR + 192), r4n = *(const f32x4*)(bq + SSTR + 256);
                    float vvn = bvp[SSTR];
#pragma unroll
                    for (int tt = 0; tt < ST; ++tt) {
                        const int tn = tt + 2 < ST ? tt + 2 : ST - 1; const float* nb = bq + tn * SSTR;
                        const f32x4 w4m = *(const f32x4*)(nb), kdm = *(const f32x4*)(nb + 64), bvm = *(const f32x4*)(nb + 128), kkm = *(const f32x4*)(nb + 192), r4m = *(const f32x4*)(nb + 256);
                        const float vvm = bvp[tn * SSTR];
                        f32x2_t p2 = s01 * kk.xy; p2 = s23 * kk.zw + p2;
                        float pp = p2.x + p2.y;
                        pp = rowsum16(pp);
                        const f32x2_t vv2 = {vv, vv}, npp = {-pp, -pp};
                        f32x2_t t01 = s01 * w4.xy + vv2 * kd.xy, t23 = s23 * w4.zw + vv2 * kd.zw;
                        s01 = npp * bv.xy + t01; s23 = npp * bv.zw + t23;
                        f32x2_t q2 = s01 * r4.xy; q2 = s23 * r4.zw + q2;
                        float yq = q2.x + q2.y;
                        yq += dppf<0x128>(yq);
                        ypw[tt * 128] = yq;
                        w4 = w4n; kd = kdn; bv = bvn; kk = kkn; r4 = r4n; vv = vvn;
                        w4n = w4m; kdn = kdm; bvn = bvm; kkn = kkm; r4n = r4m; vvn = vvm;
                    }
                }
                __syncthreads();
            }
        }
        __syncthreads();
    }
}

__device__ __forceinline__ void phase_post(const Params& p, int l) {
    const int tid = fresh_tid(), lane = tid & 63, wave = tid >> 6, c = 8 * lane, hd = lane >> 3;
    const float* y0 = (const float*)(p.ws + WS_ZR); const float* y1 = y0 + (size_t)MTOK * RW;
    const bf16_t* V = (const bf16_t*)(p.ws + WS_V); const float* coef = (const float*)(p.ws + WS_COEF); bf16_t* ymix = (bf16_t*)(p.ws + WS_U);
    float lg[8], lb[8];
#pragma unroll
    for (int e = 0; e < 8; ++e) { lg[e] = p.in[I_LNG][l * RW + c + e]; lb[e] = p.in[I_LNB][l * RW + c + e]; }
    const int stride = gridDim.x * 8; const __amdgpu_buffer_rsrc_t wsr = ws_rsrc(p.ws);
    for (int mA = blockIdx.x * 8 + wave; mA < MTOK; mA += 2 * stride) {
        const int mB = mA + stride < MTOK ? mA + stride : mA;
        f32x4 ya[2][2], yb[2][2]; u32x4 vw[2], gw[2]; float cf[2];
#pragma unroll
        for (int r = 0; r < 2; ++r) { const size_t m = (size_t)(r ? mB : mA);
            ya[r][0] = *(const f32x4*)(y0 + m * RW + c); ya[r][1] = *(const f32x4*)(y0 + m * RW + c + 4); yb[r][0] = *(const f32x4*)(y1 + m * RW + c); yb[r][1] = *(const f32x4*)(y1 + m * RW + c + 4);
            vw[r] = *(const u32x4*)(V + m * RW + c); gw[r] = *(const u32x4*)(ymix + m * 1024 + c); cf[r] = coef[m * 8 + hd]; }
        asm volatile("s_waitcnt vmcnt(0)" ::: "memory");
#pragma unroll
        for (int r = 0; r < 2; ++r) { const size_t m = (size_t)(r ? mB : mA);
            float y[8];
#pragma unroll
            for (int e = 0; e < 4; ++e) { y[e] = ya[r][0][e] + yb[r][0][e]; y[4 + e] = ya[r][1][e] + yb[r][1][e]; }
            float s1 = 0.f;
#pragma unroll
            for (int e = 0; e < 8; ++e) s1 += y[e];
            s1 += __shfl_xor(s1, 1); s1 += __shfl_xor(s1, 2); s1 += __shfl_xor(s1, 4);
            const float mean = s1 * (1.f / 64.f);
            float s2 = 0.f;
#pragma unroll
            for (int e = 0; e < 8; ++e) { y[e] -= mean; s2 += y[e] * y[e]; }
            s2 += __shfl_xor(s2, 1); s2 += __shfl_xor(s2, 2); s2 += __shfl_xor(s2, 4);
            const float rs = rsqrtf(s2 * (1.f / 64.f) + 64e-5f);
            float o[8];
#pragma unroll
            for (int e = 0; e < 4; ++e) { const unsigned vv = vw[r][e], gg = gw[r][e];
                o[2 * e] = (y[2 * e] * rs * lg[2 * e] + lb[2 * e] + cf[r] * bflo(vv)) * bflo(gg);
                o[2 * e + 1] = (y[2 * e + 1] * rs * lg[2 * e + 1] + lb[2 * e + 1] + cf[r] * bfhi(vv)) * bfhi(gg); }
            u32x4 w; w.x = cvt_pk_bf16(o[0], o[1]); w.y = cvt_pk_bf16(o[2], o[3]); w.z = cvt_pk_bf16(o[4], o[5]); w.w = cvt_pk_bf16(o[6], o[7]);
            if (r == 0 || mB != mA) st16_wt(wsr, WS_U + (m * 1024 + c) * 2, w);
        }
    }
}

__device__ __forceinline__ void fast_grid_barrier(unsigned* bar, unsigned k) {
    asm volatile("s_waitcnt vmcnt(0)" ::: "memory");
    __syncthreads();
    if (threadIdx.x == 0) {
        const unsigned G = gridDim.x, g = blockIdx.x & 7u, ng = G < 8u ? G : 8u, gsz = (G + 7u - g) >> 3;
        __builtin_amdgcn_fence(__ATOMIC_RELEASE, "agent");
        asm volatile("s_waitcnt vmcnt(0)" ::: "memory");
        const unsigned old = __hip_atomic_fetch_add(bar + 64 * (g + 1), 1u, __ATOMIC_RELAXED, __HIP_MEMORY_SCOPE_AGENT);
        if (old + 1u == k * gsz) __hip_atomic_fetch_add(bar, 1u, __ATOMIC_RELAXED, __HIP_MEMORY_SCOPE_AGENT);
        unsigned spins = 0;
        while (__hip_atomic_load(bar, __ATOMIC_RELAXED, __HIP_MEMORY_SCOPE_AGENT) < k * ng) { __builtin_amdgcn_s_sleep(1); if (++spins > (1u << 22)) break; }
        __builtin_amdgcn_fence(__ATOMIC_ACQUIRE, "agent");
        asm volatile("s_waitcnt vmcnt(0)" ::: "memory");
    }
    __syncthreads();
}

#ifndef GA
#define GA true
#endif
#ifndef GS
#define GS true
#endif
#ifndef PROBE_S
#define PROBE_S -1
#endif
#ifndef PHM
#define PHM 0xFFFF
#endif
#ifndef ONE_LAUNCH
#define ONE_LAUNCH 1
#endif
__global__ void __launch_bounds__(512, 2) hybrid_fwd(Params p_) {
    extern __shared__ __attribute__((aligned(16))) unsigned char lds_raw[];
    float* ldsf = (float*)lds_raw;
    LAS unsigned char* ldsa = (LAS unsigned char*)lds_raw;
    const int G = gridDim.x, bx = blockIdx.x;
    const int ph_lo = p_.lo, ph_hi = p_.hi;
    for (int ph = ph_lo; ph < ph_hi; ++ph) {
        typedef const __attribute__((address_space(4))) Params* kparg_t;
        kparg_t pp = (kparg_t)__builtin_amdgcn_kernarg_segment_ptr();
        asm volatile("" : "+s"(pp));
        Params p;
#pragma unroll
        for (int i = 0; i < 24; ++i) p.in[i] = pp->in[i];
        p.out = pp->out; p.ws = pp->ws; p.lo = ph_lo; p.hi = ph_hi;
        if (ph == 0) { if (blockIdx.x == 0 && threadIdx.x < 9) ((unsigned*)(p.ws + WS_BAR))[64 * threadIdx.x] = 0u;
            if (PHM & 0x400) phase_mod(p, ldsf); __syncthreads(); phase_conv(p, 0, ldsf); }
        else {
            const int l = (ph - 1) / 10, s = (ph - 1) % 10;
            for (int rep = 0; rep < (s == PROBE_S ? 2 : 1); ++rep) {
            if (rep) __syncthreads();
            if (s == 1 || s == 6 || s == 8 || s == 9) {
                if (PHM & 2) {
                const int mode = s == 1 ? 0 : (s == 8 ? 2 : (s == 6 ? 3 : 1));
                const size_t aoff = s == 9 ? WS_ACT : WS_U, boff = s == 1 ? WS_W1 : (s == 6 ? WS_W2 : (s == 8 ? WS_W3 : WS_W4));
                const int N = s == 1 ? NPAD1 : (s == 8 ? 2 * DFF : DM), K = s == 9 ? DFF : DM;
                pg8::Gemm g{(const bf16_t*)(p.ws + aoff), (const bf16_t*)(p.ws + boff), MTOK, N, K}; pg8::StaticOrder S; S.init(MTOK, N, G, bx);
                EpiAny E{mode, p.ws, l == 0 ? p.in[I_X] : p.out, p.out, l * NB * 6144 + 5 * DM, l * NB * 6144 + 2 * DM};
                pg8::gemm_phase<EpiAny, pg8::StaticOrder, GA, GS>(ldsa, g, S, E);
                }
            } else switch (s) {
            case 0: if (PHM & 1) { if (l > 0) phase_conv(p, l, ldsf); __syncthreads(); phase_norm(p, l, 0, l == 0 ? p.in[I_X] : p.out, ldsf); } break;
            case 2: if (PHM & 4) phase_attn(p, l, ldsf); break;
            case 3: if (PHM & 8) phase_prep(p, l, ldsf); break;
            case 4: if (PHM & 16) phase_scan(p, l, ldsf); break;
            case 5: if (PHM & 32) phase_post(p, l); break;
            case 7: if (PHM & 128) phase_norm(p, l, 1, l == 0 ? p.in[I_X] : p.out, ldsf); break;
            }
            }
        }
        __syncthreads();
#if ONE_LAUNCH
        if (ph + 1 < ph_hi) { if (ph == 0) cg::this_grid().sync(); else fast_grid_barrier((unsigned*)(p.ws + WS_BAR), (unsigned)ph); }
#endif
    }
}

extern "C" void kernel_launch(void* const* d_in, const int* in_sizes, int n_in, void* d_out, int out_size, void* d_ws, size_t ws_size, hipStream_t stream) {
    static int grid = 0;
    if (grid == 0) {
        if (n_in != 24 || out_size != MTOK * DM || ws_size < WS_END) { fprintf(stderr, "kernel_launch: unexpected shapes / workspace (n_in %d, out %d, ws %zu)\n", n_in, out_size, ws_size); grid = -1; return; }
        int dev = 0, cus = 0;
        if (hipGetDevice(&dev) != hipSuccess || hipDeviceGetAttribute(&cus, hipDeviceAttributeMultiprocessorCount, dev) != hipSuccess) { grid = -1; return; }
        if (hipFuncSetAttribute((const void*)hybrid_fwd, hipFuncAttributeMaxDynamicSharedMemorySize, LDS_BYTES) != hipSuccess) { grid = -1; return; }
        grid = cus;
    }
    if (grid < 0) return;
    Params p{};
    for (int i = 0; i < 24; ++i) p.in[i] = (const float*)d_in[i];
    p.out = (float*)d_out; p.ws = (unsigned char*)d_ws;
#if ONE_LAUNCH
    p.lo = 0; p.hi = NPHASE;
    void* args[] = {&p};
    hipError_t e = hipLaunchCooperativeKernel((const void*)hybrid_fwd, dim3(grid), dim3(512), args, LDS_BYTES, stream);
    if (e != hipSuccess) fprintf(stderr, "cooperative launch failed: %s (grid %d)\n", hipGetErrorString(e), grid);
#else
    for (int ph = 0; ph < NPHASE; ++ph) { p.lo = ph; p.hi = ph + 1; hipLaunchKernelGGL(hybrid_fwd, dim3(grid), dim3(512), LDS_BYTES, stream, p); }
#endif
}
```

```cpp
#include <hip/hip_runtime.h>
#include <hip/hip_cooperative_groups.h>
#include <cstdio>
#include <cstdint>
__device__ __forceinline__ int fresh_tid() { int t = threadIdx.x; asm volatile("" : "+v"(t)); return t; }
namespace pg8 {
#define PG8_LAS __attribute__((address_space(3)))
typedef unsigned short bf16_t;
typedef short bf16x8 __attribute__((ext_vector_type(8)));
typedef float f32x4 __attribute__((ext_vector_type(4)));
typedef unsigned u32x4 __attribute__((ext_vector_type(4)));
constexpr int BM = 256, BK = 64, HALF = 128, HTB = HALF * BK * 2  , STAGE_BYTES = 8 * HTB, NXCD = 8, WGM = 8;

__host__ __device__ __forceinline__ int lds_byte(int r, int c) { const int st = (r >> 4) * 2 + (c >> 5), rr = r & 15, cc = c & 31, ob = rr * 64 + cc * 2; return st * 1024 + (ob ^ (((ob >> 9) & 1) << 5)); }
__host__ __device__ __forceinline__ void stage_rc(int b, int& R, int& C) { const int st = b / 1024, sb = b % 1024, swz = sb ^ (((sb >> 9) & 1) << 5); R = (st >> 1) * 16 + swz / 64; C = (st & 1) * 32 + (swz % 64) / 2; }
__host__ __device__ __forceinline__ int perm32(int rho) { const int n = rho >> 4, i = rho & 15; return 8 * (i >> 2) + 4 * n + (i & 3); }

struct Unit { int pm, pn; };
struct Gemm { const bf16_t* A; const bf16_t* Bt; int M, N, K; };

struct StaticOrder {
    int nM, nN, nwg, G, c;
    __host__ __device__ void init(int M, int N, int G_, int c_) { nM = M / BM; nN = N / BM; nwg = nM * nN; G = G_; c = c_; }
    __host__ __device__ bool next(int i, Unit& u) const {
        const long L = (long)i * G + c; if (L >= nwg) return false;
        int wgid = (int)L; { const int q = nwg / NXCD, r = nwg % NXCD, xcd = wgid % NXCD, off = wgid / NXCD; wgid = (xcd < r ? xcd * (q + 1) : r * (q + 1) + (xcd - r) * q) + off; }
        const int nig = WGM * nN, gid = wgid / nig, fm = gid * WGM, gsz = (nM - fm) < WGM ? (nM - fm) : WGM;
        u.pm = fm + ((wgid % nig) % gsz); u.pn = (wgid % nig) / gsz; return true;
    }
    __device__ __forceinline__ void a_ready(const Unit&) const {}
    __device__ __forceinline__ void done(const Unit&) const {}
};

typedef float f32x2c_t __attribute__((ext_vector_type(2))); typedef __bf16 bf16x2c_t __attribute__((ext_vector_type(2)));
__device__ __forceinline__ unsigned cvt_pk_bf16(float lo, float hi) { f32x2c_t v = {lo, hi}; bf16x2c_t b = __builtin_convertvector(v, bf16x2c_t); return __builtin_bit_cast(unsigned, b); }
typedef float f32x2 __attribute__((ext_vector_type(2)));
template <class Epi, class Sched, bool ALIGN_EPI = false, bool SP2 = false>
__device__ __forceinline__ void gemm_phase(PG8_LAS unsigned char* lds, const Gemm g, const Sched& S, const Epi& E) {
    const int tid = ::fresh_tid(), wid = __builtin_amdgcn_readfirstlane(tid >> 6), lane = tid & 63, wr = wid >> 2, wc = wid & 3, fr = lane & 15, fq = lane >> 4;
    const int K = g.K, nt = K / BK;
    unsigned voffA[2], voffB[2];
#pragma unroll
    for (int i = 0; i < 2; ++i) { int R, C; stage_rc(tid * 16 + i * 8192, R, C); const int Rb = Epi::PERM ? ((R & ~31) + perm32(R & 31)) : R;
        voffA[i] = (unsigned)(R * K + C) * 2u; voffB[i] = (unsigned)(Rb * K + C) * 2u; }
    const size_t kstep = (size_t)(BK * 2);
    const size_t hstep = (size_t)HALF * K * 2;
    const size_t tstep = 2 * hstep;
    const unsigned ldsw = (unsigned)wid * 1024u;
    const int aoff = lds_byte(wr * 64 + fr, fq * 8), boff = lds_byte(wc * 32 + fr, fq * 8);
#define PG8_SA(b, h) (((b) * 2 + (h)) * HTB)
#define PG8_SB(b, h) ((4 + (b) * 2 + (h)) * HTB)
#define PG8_STAGE(bufoff, gbase, voff) do { _Pragma("unroll") for (int _i = 0; _i < 2; ++_i) \
        __builtin_amdgcn_global_load_lds((const unsigned*)((const char*)(gbase) + (voff)[_i]), (PG8_LAS unsigned*)(lds + (bufoff) + ldsw + _i * 8192), 16, 0, 0); } while (0)
#define PG8_LDA(dst, b, h) do { _Pragma("unroll") for (int m = 0; m < 4; ++m) _Pragma("unroll") for (int k = 0; k < 2; ++k) dst[m][k] = *(const PG8_LAS bf16x8*)(lds + PG8_SA(b, h) + aoff + m * 2048 + k * 1024); } while (0)
#define PG8_LDB(dst, b, h) do { _Pragma("unroll") for (int n = 0; n < 2; ++n) _Pragma("unroll") for (int k = 0; k < 2; ++k) dst[n][k] = *(const PG8_LAS bf16x8*)(lds + PG8_SB(b, h) + boff + n * 2048 + k * 1024); } while (0)
#define PG8_MMA(ai, bj, At, Bt) do { __builtin_amdgcn_s_setprio(1); _Pragma("unroll") for (int m = 0; m < 4; ++m) _Pragma("unroll") for (int n = 0; n < 2; ++n) _Pragma("unroll") for (int k = 0; k < 2; ++k) \
        acc[ai][bj][m][n] = __builtin_amdgcn_mfma_f32_16x16x32_bf16(Bt[n][k], At[m][k], acc[ai][bj][m][n], 0, 0, 0); __builtin_amdgcn_s_setprio(0); } while (0)
#define PG8_WAIT_V(n) asm volatile("s_waitcnt vmcnt(" #n ")" ::: "memory")
#define PG8_WAIT_L(n) asm volatile("s_waitcnt lgkmcnt(" #n ")" ::: "memory")
#define PG8_BAR __builtin_amdgcn_s_barrier()
#define PG8_SCHED __builtin_amdgcn_sched_barrier(0)
    Unit cur, nxt; int ui = 0;
    if (!S.next(0, cur)) return;
    f32x4 acc[2][2][4][2];
#pragma unroll
    for (int a = 0; a < 2; ++a)
#pragma unroll
        for (int b = 0; b < 2; ++b)
#pragma unroll
            for (int m = 0; m < 4; ++m)
#pragma unroll
                for (int n = 0; n < 2; ++n) acc[a][b][m][n] = (f32x4){0.f, 0.f, 0.f, 0.f};
    bf16x8 At[4][2], B0[2][2], B1[2][2];
    const char* cA = (const char*)g.A + (size_t)cur.pm * tstep; const char* cB = (const char*)g.Bt + (size_t)cur.pn * tstep;
    S.a_ready(cur);
    if constexpr (SP2) {
        PG8_STAGE(PG8_SB(0, 0), cB, voffB); PG8_STAGE(PG8_SB(0, 1), cB + hstep, voffB); PG8_STAGE(PG8_SA(0, 0), cA, voffA); PG8_STAGE(PG8_SA(0, 1), cA + hstep, voffA);
        if (wr == 1) PG8_BAR;
        PG8_WAIT_V(2); PG8_BAR;
        PG8_STAGE(PG8_SB(1, 0), cB + kstep, voffB); PG8_STAGE(PG8_SA(1, 0), cA + kstep, voffA); PG8_STAGE(PG8_SB(1, 1), cB + hstep + kstep, voffB);
        PG8_WAIT_V(6); PG8_BAR;
    } else {
        PG8_STAGE(PG8_SB(0, 0), cB, voffB); PG8_STAGE(PG8_SA(0, 0), cA, voffA); PG8_STAGE(PG8_SB(0, 1), cB + hstep, voffB); PG8_STAGE(PG8_SA(0, 1), cA + hstep, voffA);
        if (wr == 1) PG8_BAR;
        PG8_WAIT_V(4); PG8_BAR;
        PG8_STAGE(PG8_SB(1, 0), cB + kstep, voffB); PG8_STAGE(PG8_SA(1, 0), cA + kstep, voffA); PG8_STAGE(PG8_SB(1, 1), cB + hstep + kstep, voffB);
        PG8_WAIT_V(6); PG8_BAR;
    }
    for (;;) {
        const bool has_next = S.next(ui + 1, nxt);
        const char* nA = has_next ? (const char*)g.A + (size_t)nxt.pm * tstep : cA; const char* nB = has_next ? (const char*)g.Bt + (size_t)nxt.pn * tstep : cB;
        for (int t = 0; t < nt; t += 2) {
            const bool last = (t == nt - 2);
            const char* a1 = cA + (size_t)(t + 1) * kstep;
            const char* a2 = last ? nA : cA + (size_t)(t + 2) * kstep; const char* b2 = last ? nB : cB + (size_t)(t + 2) * kstep;
            const char* a3 = a2 + kstep; const char* b3 = b2 + kstep;
            if (last && has_next) S.a_ready(nxt);
            if constexpr (SP2) {
            PG8_LDB(B0, 0, 0); PG8_LDB(B1, 0, 1); PG8_SCHED; PG8_LDA(At, 0, 0); PG8_STAGE(PG8_SA(1, 1), a1 + hstep, voffA);
            PG8_WAIT_V(8); PG8_WAIT_L(0); PG8_BAR; PG8_MMA(0, 0, At, B0); PG8_MMA(0, 1, At, B1); PG8_BAR; PG8_SCHED;
            PG8_LDA(At, 0, 1); PG8_STAGE(PG8_SB(0, 0), b2, voffB); PG8_STAGE(PG8_SB(0, 1), b2 + hstep, voffB); PG8_STAGE(PG8_SA(0, 0), a2, voffA);
            PG8_WAIT_V(8); PG8_WAIT_L(0); PG8_BAR; PG8_MMA(1, 0, At, B0); PG8_MMA(1, 1, At, B1); PG8_BAR; PG8_SCHED;
            PG8_LDB(B0, 1, 0); PG8_LDB(B1, 1, 1); PG8_SCHED; PG8_LDA(At, 1, 0); PG8_STAGE(PG8_SA(0, 1), a2 + hstep, voffA);
            PG8_WAIT_V(8); PG8_WAIT_L(0); PG8_BAR; PG8_MMA(0, 0, At, B0); PG8_MMA(0, 1, At, B1); PG8_BAR; PG8_SCHED;
            PG8_LDA(At, 1, 1); PG8_STAGE(PG8_SB(1, 0), b3, voffB); PG8_STAGE(PG8_SB(1, 1), b3 + hstep, voffB); PG8_STAGE(PG8_SA(1, 0), a3, voffA);
            PG8_WAIT_V(8); PG8_WAIT_L(0); PG8_BAR; PG8_MMA(1, 0, At, B0); PG8_MMA(1, 1, At, B1); PG8_BAR; PG8_SCHED;
            } else {
            PG8_LDB(B0, 0, 0); PG8_SCHED; PG8_LDA(At, 0, 0); PG8_STAGE(PG8_SA(1, 1), a1 + hstep, voffA);
            PG8_WAIT_L(8); PG8_BAR; PG8_WAIT_L(0); PG8_MMA(0, 0, At, B0); PG8_BAR; PG8_SCHED;
            PG8_LDB(B1, 0, 1); PG8_STAGE(PG8_SB(0, 0), b2, voffB);
            PG8_BAR; PG8_WAIT_L(0); PG8_MMA(0, 1, At, B1); PG8_BAR;
            PG8_LDA(At, 0, 1); PG8_STAGE(PG8_SA(0, 0), a2, voffA);
            PG8_BAR; PG8_WAIT_L(0); PG8_MMA(1, 0, At, B0); PG8_BAR; PG8_SCHED;
            PG8_STAGE(PG8_SB(0, 1), b2 + hstep, voffB);
            PG8_WAIT_V(6); PG8_BAR; PG8_MMA(1, 1, At, B1); PG8_BAR;
            PG8_LDB(B0, 1, 0); PG8_SCHED; PG8_LDA(At, 1, 0); PG8_STAGE(PG8_SA(0, 1), a2 + hstep, voffA);
            PG8_WAIT_L(8); PG8_BAR; PG8_WAIT_L(0); PG8_MMA(0, 0, At, B0); PG8_BAR; PG8_SCHED;
            PG8_LDB(B1, 1, 1); PG8_STAGE(PG8_SB(1, 0), b3, voffB);
            PG8_BAR; PG8_WAIT_L(0); PG8_MMA(0, 1, At, B1); PG8_BAR;
            PG8_LDA(At, 1, 1); PG8_STAGE(PG8_SA(1, 0), a3, voffA);
            PG8_BAR; PG8_WAIT_L(0); PG8_MMA(1, 0, At, B0); PG8_BAR; PG8_SCHED;
            PG8_STAGE(PG8_SB(1, 1), b3 + hstep, voffB);
            PG8_WAIT_V(6); PG8_BAR; PG8_MMA(1, 1, At, B1); PG8_BAR;
            }
        }
        if constexpr (ALIGN_EPI) { if (wr == 0) PG8_BAR; }
        if constexpr (!Epi::AFTER_DRAIN) { E(acc, cur, wr, wc, fr, fq); S.done(cur); }
        if (!has_next) break;
#pragma unroll
        for (int a = 0; a < 2; ++a)
#pragma unroll
            for (int b = 0; b < 2; ++b)
#pragma unroll
                for (int m = 0; m < 4; ++m)
#pragma unroll
                    for (int n = 0; n < 2; ++n) acc[a][b][m][n] = (f32x4){0.f, 0.f, 0.f, 0.f};
        cur = nxt; cA = nA; cB = nB; ++ui;
        if constexpr (ALIGN_EPI) { if (wr == 1) PG8_BAR; }
    }
    PG8_WAIT_V(0);
    if constexpr (!ALIGN_EPI) { if (wr == 0) PG8_BAR; }
    PG8_BAR;
    if constexpr (Epi::AFTER_DRAIN) { E.fused(acc, cur, wr, wc, fr, fq, lds, wid, lane); S.done(cur); }
#undef PG8_SA
#undef PG8_SB
#undef PG8_STAGE
#undef PG8_LDA
#undef PG8_LDB
#undef PG8_MMA
#undef PG8_WAIT_V
#undef PG8_WAIT_L
#undef PG8_BAR
#undef PG8_SCHED
}
}

namespace cg = cooperative_groups;
using pg8::bf16_t; using pg8::bf16x8; using pg8::f32x4; using pg8::u32x4; using pg8::cvt_pk_bf16;
#define LAS __attribute__((address_space(3)))
typedef unsigned u32x2 __attribute__((ext_vector_type(2)));

constexpr int NB = 4, SEQ = 8192, DM = 1024, MTOK = NB * SEQ, NLAYER = 4;
constexpr int RW = 512, RWKV_COLS = 1920, IN_COLS = 3456, NPAD1 = 3584, DFF = 2816;
constexpr size_t MiB = 1u << 20;
constexpr size_t WS_W1 = 0, WS_W2 = 7 * MiB, WS_W3 = 9 * MiB, WS_W4 = 20 * MiB, WS_MOD = 26 * MiB, WS_COEF = 27 * MiB, WS_RSTD = 28 * MiB;
constexpr size_t WS_WL = 25 * MiB + 512 * 1024;
constexpr size_t WS_QKG = 29 * MiB;
constexpr size_t WS_BAR = 29 * MiB + 65536;
constexpr size_t WS_U = 30 * MiB;
constexpr size_t WS_QK = 94 * MiB, WS_VT = 158 * MiB;
constexpr size_t WS_R = 94 * MiB, WS_K = 126 * MiB, WS_V = 158 * MiB;
constexpr size_t WS_ZR = 190 * MiB;
constexpr size_t WS_E0 = 318 * MiB, WS_E1 = 350 * MiB, WS_A0 = 382 * MiB, WS_A1 = 414 * MiB;
constexpr size_t WS_DELTA = 318 * MiB;
constexpr size_t WS_ACT = 94 * MiB;
constexpr size_t WS_END = 446 * MiB;
constexpr int LDS_BYTES = 147456;
constexpr int NPHASE = 1 + 10 * NLAYER;

struct Params { const float* in[24]; float* out; unsigned char* ws; int lo, hi; };
enum { I_X = 0, I_C, I_ADAW, I_ADAB, I_N1G, I_N2G, I_WIN, I_MU, I_W0, I_W2, I_A0, I_A2, I_G2, I_KK, I_KA, I_RK, I_LNG, I_LNB, I_QG, I_KG, I_RPB, I_WOUT, I_FIN, I_FOUT };

__device__ __forceinline__ int fresh_tid();
__device__ __forceinline__ __amdgpu_buffer_rsrc_t ws_rsrc(unsigned char* ws) { return __builtin_amdgcn_make_buffer_rsrc(ws, 0, 0x20000000, 0x00020000); }
__device__ __forceinline__ void st16_wt(__amdgpu_buffer_rsrc_t r, size_t off, u32x4 v) { __builtin_amdgcn_raw_buffer_store_b128(v, r, (int)off, 0, 16); }
__device__ __forceinline__ float bf2f(unsigned short v) { return __builtin_bit_cast(float, (unsigned)v << 16); }
__device__ __forceinline__ float bflo(unsigned w) { return __builtin_bit_cast(float, w << 16); }
__device__ __forceinline__ float bfhi(unsigned w) { return __builtin_bit_cast(float, w & 0xffff0000u); }
__device__ __forceinline__ unsigned short f2bf(float f) { return (unsigned short)(cvt_pk_bf16(f, 0.f) & 0xffffu); }
__device__ __forceinline__ float wave_sum(float v) {
#pragma unroll
    for (int o = 32; o >= 1; o >>= 1) v += __shfl_xor(v, o);
    return v;
}
__device__ __forceinline__ float sigmoidf_(float x) { return __builtin_amdgcn_rcpf(1.f + __expf(-x)); }
template <int CTRL> __device__ __forceinline__ float dppf(float x) { return __builtin_bit_cast(float, __builtin_amdgcn_update_dpp(0, __builtin_bit_cast(int, x), CTRL, 0xF, 0xF, false)); }
__device__ __forceinline__ float rowsum16(float x) { x += dppf<0x128>(x); x += dppf<0x124>(x); x += dppf<0x122>(x); x += dppf<0x121>(x); return x; }

__device__ __forceinline__ void phase_mod(const Params& p, float* lds) {
    const int tid = fresh_tid();
    const float* c = p.in[I_C]; const float* aw = p.in[I_ADAW]; const float* ab = p.in[I_ADAB];
    float* mod = (float*)(p.ws + WS_MOD);
    for (int i = tid; i < NB * DM; i += 512) { const float v = c[i]; lds[i] = v / (1.f + __expf(-v)); }
    __syncthreads();
    float* red = lds + NB * DM;
    const int cl = tid & 63, kp = tid >> 6;
    for (int item = blockIdx.x; item < NLAYER * 96; item += gridDim.x) {
        const int l = item / 96, n = (item % 96) * 64 + cl;
        const float* wp = aw + ((size_t)l * DM + kp * 128) * 6144 + n;
        float a0 = 0.f, a1 = 0.f, a2 = 0.f, a3 = 0.f;
#pragma unroll 8
        for (int k = 0; k < 128; ++k) { const float w = wp[(size_t)k * 6144]; const int kk = kp * 128 + k;
            a0 += w * lds[kk]; a1 += w * lds[DM + kk]; a2 += w * lds[2 * DM + kk]; a3 += w * lds[3 * DM + kk]; }
        red[(kp * 4 + 0) * 64 + cl] = a0; red[(kp * 4 + 1) * 64 + cl] = a1; red[(kp * 4 + 2) * 64 + cl] = a2; red[(kp * 4 + 3) * 64 + cl] = a3;
        __syncthreads();
        if (tid < 256) { const int b = tid >> 6; float s = ab[l * 6144 + n];
#pragma unroll
            for (int q = 0; q < 8; ++q) s += red[(q * 4 + b) * 64 + cl];
            mod[(size_t)(l * NB + b) * 6144 + n] = s; }
        __syncthreads();
    }
}

__device__ __forceinline__ void phase_conv(const Params& p, int l, float* tile) {
    const int tid = fresh_tid();
    constexpr int T1 = (NPAD1 / 64) * 16, T2 = 16 * 16, T3 = (2 * DFF / 64) * 16, T4 = 16 * (DFF / 64);
    for (int it = blockIdx.x; it < T1 + T2 + T3 + T4; it += gridDim.x) {
        int mode, nt, kt, K, Nsrc; const float* src; bf16_t* dst;
        if (it < T1) { mode = 1; nt = it / 16; kt = it % 16; K = DM; Nsrc = IN_COLS; src = p.in[I_WIN] + (size_t)l * DM * IN_COLS; dst = (bf16_t*)(p.ws + WS_W1); }
        else if (it < T1 + T2) { const int i2 = it - T1; mode = 2; nt = i2 / 16; kt = i2 % 16; K = DM; Nsrc = DM; src = p.in[I_WOUT] + (size_t)l * DM * DM; dst = (bf16_t*)(p.ws + WS_W2); }
        else if (it < T1 + T2 + T3) { const int i3 = it - T1 - T2; mode = 3; nt = i3 / 16; kt = i3 % 16; K = DM; Nsrc = 2 * DFF; src = p.in[I_FIN] + (size_t)l * DM * 2 * DFF; dst = (bf16_t*)(p.ws + WS_W3); }
        else { const int i4 = it - T1 - T2 - T3; mode = 4; nt = i4 / 44; kt = i4 % 44; K = DFF; Nsrc = DM; src = p.in[I_FOUT] + (size_t)l * DFF * DM; dst = (bf16_t*)(p.ws + WS_W4); }
        {
            const int nn = tid & 63, kk = tid >> 6, np = nt * 64 + nn; int col;
            if (mode == 1) { const int pn = np >> 8, pp = np & 255, bj = pp >> 7, wc = (pp >> 5) & 3, cc = pp & 31; const int L = 256 * pn + 64 * wc + 32 * bj + cc;
                col = L < 1536 ? RWKV_COLS + L : (L < IN_COLS ? L - 1536 : -1); }
            else if (mode == 3) { const int pn = np >> 8, bj = (np >> 7) & 1, i = np & 127; col = bj * DFF + 128 * pn + i; }
            else col = np;
#pragma unroll
            for (int kr = 0; kr < 8; ++kr) { const int k = kk + 8 * kr; tile[k * 65 + nn] = col >= 0 ? src[(size_t)(kt * 64 + k) * Nsrc + col] : 0.f; }
        }
        __syncthreads();
        {
            const int nn = tid >> 3, kc = tid & 7; u32x4 w;
            w.x = cvt_pk_bf16(tile[(8 * kc + 0) * 65 + nn], tile[(8 * kc + 1) * 65 + nn]); w.y = cvt_pk_bf16(tile[(8 * kc + 2) * 65 + nn], tile[(8 * kc + 3) * 65 + nn]);
            w.z = cvt_pk_bf16(tile[(8 * kc + 4) * 65 + nn], tile[(8 * kc + 5) * 65 + nn]); w.w = cvt_pk_bf16(tile[(8 * kc + 6) * 65 + nn], tile[(8 * kc + 7) * 65 + nn]);
            *(u32x4*)(dst + (size_t)(nt * 64 + nn) * K + kt * 64 + 8 * kc) = w;
        }
        __syncthreads();
    }
    {
        bf16_t* WL = (bf16_t*)(p.ws + WS_WL);
        for (int idx = blockIdx.x * 512 + tid; idx < 512 * 48; idx += gridDim.x * 512) { const int col = idx & 511, kc = idx >> 9, k0 = 8 * kc;
            const float* src;
            if (k0 < 128) src = p.in[I_W2] + ((size_t)(l * 2 + (k0 >> 6)) * 64 + (k0 & 63)) * RW + col;
            else if (k0 < 256) src = p.in[I_A2] + ((size_t)(l * 2 + ((k0 - 128) >> 6)) * 64 + (k0 & 63)) * RW + col;
            else src = p.in[I_G2] + ((size_t)l * 128 + (k0 - 256)) * RW + col;
            u32x4 w; w.x = cvt_pk_bf16(src[0], src[RW]); w.y = cvt_pk_bf16(src[2 * RW], src[3 * RW]); w.z = cvt_pk_bf16(src[4 * RW], src[5 * RW]); w.w = cvt_pk_bf16(src[6 * RW], src[7 * RW]);
            *(u32x4*)(WL + (size_t)col * 384 + k0) = w; }
    }
}

__device__ __forceinline__ void phase_norm(const Params& p, int l, int which, const float* h, float* lds) {
    const int tid = fresh_tid(), lane = tid & 63, wave = tid >> 6;
    const float* mod = (const float*)(p.ws + WS_MOD) + (size_t)l * NB * 6144;
    const float* g = p.in[which == 0 ? I_N1G : I_N2G] + l * DM;
    float* gs = lds; float* sh = lds + NB * DM; float* g1 = lds + 2 * NB * DM;
    const bf16_t* delta = (const bf16_t*)(p.ws + WS_DELTA);
    if (which == 0 && blockIdx.x == 0 && tid < 128) ((float*)(p.ws + WS_QKG))[tid] = tid < 64 ? p.in[I_QG][l * 64 + tid] : p.in[I_KG][l * 64 + tid - 64];
    for (int i = tid; i < NB * DM; i += 512) { const int b = i >> 10, k = i & 1023;
        gs[i] = g[k] * (1.f + mod[b * 6144 + (which * 3 + 1) * DM + k]); sh[i] = mod[b * 6144 + (which * 3) * DM + k]; g1[i] = mod[b * 6144 + 2 * DM + k]; }
    __syncthreads();
    bf16_t* u = (bf16_t*)(p.ws + WS_U);
    const int stride = gridDim.x * 8;
    for (int row0 = blockIdx.x * 8 + wave; row0 < MTOK; row0 += 2 * stride) {
        const int row1 = row0 + stride < MTOK ? row0 + stride : row0;
        const float* hr0 = h + (size_t)row0 * DM; const float* hr1 = h + (size_t)row1 * DM;
        f32x4 v0[4], v1[4]; float ss0 = 0.f, ss1 = 0.f;
#pragma unroll
        for (int q = 0; q < 4; ++q) { v0[q] = __builtin_nontemporal_load((const f32x4*)(hr0 + 4 * lane + 256 * q)); v1[q] = __builtin_nontemporal_load((const f32x4*)(hr1 + 4 * lane + 256 * q)); }
        if (which == 1) {
            const int bb0 = row0 >> 13, bb1 = row1 >> 13;
#pragma unroll
            for (int q = 0; q < 4; ++q) { const int k = 4 * lane + 256 * q;
                const u32x2 d0 = *(const u32x2*)(delta + (size_t)row0 * DM + k), d1 = *(const u32x2*)(delta + (size_t)row1 * DM + k);
                const f32x4 ga = *(const f32x4*)(g1 + bb0 * DM + k), gb = *(const f32x4*)(g1 + bb1 * DM + k);
                v0[q] += ga * (f32x4){bflo(d0.x), bfhi(d0.x), bflo(d0.y), bfhi(d0.y)}; v1[q] += gb * (f32x4){bflo(d1.x), bfhi(d1.x), bflo(d1.y), bfhi(d1.y)}; }
        }
#pragma unroll
        for (int q = 0; q < 4; ++q) { ss0 += v0[q][0] * v0[q][0] + v0[q][1] * v0[q][1] + v0[q][2] * v0[q][2] + v0[q][3] * v0[q][3]; ss1 += v1[q][0] * v1[q][0] + v1[q][1] * v1[q][1] + v1[q][2] * v1[q][2] + v1[q][3] * v1[q][3]; }
        ss0 = wave_sum(ss0); ss1 = wave_sum(ss1);
        const float rstd0 = rsqrtf(ss0 * (1.f / DM) + 1e-6f), rstd1 = rsqrtf(ss1 * (1.f / DM) + 1e-6f);
        const int b0 = row0 >> 13, b1 = row1 >> 13;
#pragma unroll
        for (int q = 0; q < 4; ++q) { const int k = 4 * lane + 256 * q;
            { const f32x4 gg = *(const f32x4*)(gs + b0 * DM + k), ss4 = *(const f32x4*)(sh + b0 * DM + k);
              const f32x4 o = v0[q] * rstd0 * gg + ss4; u32x2 w; w.x = cvt_pk_bf16(o[0], o[1]); w.y = cvt_pk_bf16(o[2], o[3]); *(u32x2*)(u + (size_t)row0 * DM + k) = w; }
            { const f32x4 gg = *(const f32x4*)(gs + b1 * DM + k), ss4 = *(const f32x4*)(sh + b1 * DM + k);
              const f32x4 o = v1[q] * rstd1 * gg + ss4; u32x2 w; w.x = cvt_pk_bf16(o[0], o[1]); w.y = cvt_pk_bf16(o[2], o[3]); *(u32x2*)(u + (size_t)row1 * DM + k) = w; }
        }
    }
}

struct EpiZ {
    static constexpr bool PERM = true, AFTER_DRAIN = false;
    unsigned char* ws;
    __device__ __forceinline__ void operator()(const f32x4 (&acc)[2][2][4][2], const pg8::Unit& u, int wr, int wc, int fr, int fq) const {
        const int pn = u.pn, row0 = u.pm * 256 + wr * 64 + fr;
        bf16_t* qk = (bf16_t*)(ws + WS_QK); bf16_t* vT = (bf16_t*)(ws + WS_VT); bf16_t* zr = (bf16_t*)(ws + WS_ZR);
        const __amdgpu_buffer_rsrc_t rs = ws_rsrc(ws);
        if (pn < 4) {
            const float* gg = (const float*)(ws + WS_QKG) + (pn < 2 ? 0 : 64); const float sc = pn < 2 ? 0.125f : 1.f;
            f32x4 gv[2][2];
#pragma unroll
            for (int bj = 0; bj < 2; ++bj)
#pragma unroll
                for (int n = 0; n < 2; ++n) gv[bj][n] = *(const f32x4*)(gg + 32 * bj + 8 * fq + 4 * n) * sc;
            asm volatile("s_waitcnt vmcnt(0)" ::: "memory");
#pragma unroll
            for (int ai = 0; ai < 2; ++ai)
#pragma unroll
                for (int m = 0; m < 4; ++m) {
                    float ss = 0.f;
#pragma unroll
                    for (int bj = 0; bj < 2; ++bj)
#pragma unroll
                        for (int n = 0; n < 2; ++n) { const f32x4 a = acc[ai][bj][m][n]; ss += a[0] * a[0] + a[1] * a[1] + a[2] * a[2] + a[3] * a[3]; }
                    ss += __shfl_xor(ss, 16); ss += __shfl_xor(ss, 32);
                    const float rstd = rsqrtf(ss * (1.f / 64.f) + 1e-6f);
                    bf16_t* rowp = qk + (size_t)(row0 + ai * 128 + m * 16) * 1024 + pn * 256 + 64 * wc + 8 * fq;
#pragma unroll
                    for (int bj = 0; bj < 2; ++bj) { const f32x4 v0 = acc[ai][bj][m][0] * rstd * gv[bj][0], v1 = acc[ai][bj][m][1] * rstd * gv[bj][1];
                        u32x4 w; w.x = cvt_pk_bf16(v0[0], v0[1]); w.y = cvt_pk_bf16(v0[2], v0[3]); w.z = cvt_pk_bf16(v1[0], v1[1]); w.w = cvt_pk_bf16(v1[2], v1[3]);
                        st16_wt(rs, (size_t)((const unsigned char*)(rowp + 32 * bj) - ws), w); }
                }
        } else if (pn < 6) {
            const int h = (pn - 4) * 4 + wc;
#pragma unroll
            for (int ai = 0; ai < 2; ++ai)
#pragma unroll
                for (int m = 0; m < 4; ++m) { const int row = row0 + ai * 128 + m * 16, b = row >> 13, t = row & 8191;
                    bf16_t* base = vT + ((size_t)(b * 8 + h) * 64 + 8 * fq) * SEQ + t;
#pragma unroll
                    for (int bj = 0; bj < 2; ++bj)
#pragma unroll
                        for (int n = 0; n < 2; ++n)
#pragma unroll
                            for (int j = 0; j < 4; ++j) base[(size_t)(32 * bj + 4 * n + j) * SEQ] = f2bf(acc[ai][bj][m][n][j]);
                }
        } else {
            const int colbase = (pn - 6) * 256 + 64 * wc + 8 * fq;
#pragma unroll
            for (int ai = 0; ai < 2; ++ai)
#pragma unroll
                for (int m = 0; m < 4; ++m) { bf16_t* rowp = zr + (size_t)(row0 + ai * 128 + m * 16) * 2048 + colbase;
#pragma unroll
                    for (int bj = 0; bj < 2; ++bj) { const f32x4 v0 = acc[ai][bj][m][0], v1 = acc[ai][bj][m][1];
                        u32x4 w; w.x = cvt_pk_bf16(v0[0], v0[1]); w.y = cvt_pk_bf16(v0[2], v0[3]); w.z = cvt_pk_bf16(v1[0], v1[1]); w.w = cvt_pk_bf16(v1[2], v1[3]);
                        st16_wt(rs, (size_t)((const unsigned char*)(rowp + 32 * bj) - ws), w); }
                }
        }
    }
};

struct EpiRes {
    static constexpr bool PERM = true, AFTER_DRAIN = false;
    const float* hin; float* hout; unsigned char* ws; int gate_off; int gate1_off;
    __device__ __forceinline__ void operator()(const f32x4 (&acc)[2][2][4][2], const pg8::Unit& u, int wr, int wc, int fr, int fq) const {
        const int row0 = u.pm * 256 + wr * 64 + fr, col0 = u.pn * 256 + wc * 32 + 8 * fq, b = (u.pm * 256) >> 13;
        const float* gate = (const float*)(ws + WS_MOD) + gate_off;
        const float* gate1 = (const float*)(ws + WS_MOD) + (gate1_off < 0 ? 0 : gate1_off);
        const bf16_t* delta = (const bf16_t*)(ws + WS_DELTA);
        f32x4 gv[2][2], g1[2][2];
#pragma unroll
        for (int bj = 0; bj < 2; ++bj)
#pragma unroll
            for (int n = 0; n < 2; ++n) { gv[bj][n] = *(const f32x4*)(gate + b * 6144 + col0 + 128 * bj + 4 * n); g1[bj][n] = *(const f32x4*)(gate1 + b * 6144 + col0 + 128 * bj + 4 * n); }
#pragma unroll
        for (int ai = 0; ai < 2; ++ai)
#pragma unroll
            for (int m = 0; m < 4; ++m) { const size_t ro = (size_t)(row0 + ai * 128 + m * 16) * DM + col0;
#pragma unroll
                for (int bj = 0; bj < 2; ++bj) {
                    f32x4 h0 = *(const f32x4*)(hin + ro + 128 * bj), h1 = *(const f32x4*)(hin + ro + 128 * bj + 4);
                    if (gate1_off >= 0) { const u32x4 dw = *(const u32x4*)(delta + ro + 128 * bj);
                        h0 += g1[bj][0] * (f32x4){bflo(dw.x), bfhi(dw.x), bflo(dw.y), bfhi(dw.y)}; h1 += g1[bj][1] * (f32x4){bflo(dw.z), bfhi(dw.z), bflo(dw.w), bfhi(dw.w)}; }
                    *(f32x4*)(hout + ro + 128 * bj) = h0 + gv[bj][0] * acc[ai][bj][m][0];
                    *(f32x4*)(hout + ro + 128 * bj + 4) = h1 + gv[bj][1] * acc[ai][bj][m][1]; }
            }
    }
};

struct EpiDelta {
    static constexpr bool PERM = true, AFTER_DRAIN = false;
    unsigned char* ws;
    __device__ __forceinline__ void operator()(const f32x4 (&acc)[2][2][4][2], const pg8::Unit& u, int wr, int wc, int fr, int fq) const {
        const int row0 = u.pm * 256 + wr * 64 + fr, col0 = u.pn * 256 + wc * 32 + 8 * fq; bf16_t* delta = (bf16_t*)(ws + WS_DELTA);
        const __amdgpu_buffer_rsrc_t rs = ws_rsrc(ws);
#pragma unroll
        for (int ai = 0; ai < 2; ++ai)
#pragma unroll
            for (int m = 0; m < 4; ++m) { bf16_t* rowp = delta + (size_t)(row0 + ai * 128 + m * 16) * DM + col0;
#pragma unroll
                for (int bj = 0; bj < 2; ++bj) { const f32x4 v0 = acc[ai][bj][m][0], v1 = acc[ai][bj][m][1];
                    u32x4 w; w.x = cvt_pk_bf16(v0[0], v0[1]); w.y = cvt_pk_bf16(v0[2], v0[3]); w.z = cvt_pk_bf16(v1[0], v1[1]); w.w = cvt_pk_bf16(v1[2], v1[3]);
                    st16_wt(rs, (size_t)((const unsigned char*)(rowp + 128 * bj) - ws), w); }
            }
    }
};

struct EpiSwiglu {
    static constexpr bool PERM = true, AFTER_DRAIN = false;
    unsigned char* ws;
    __device__ __forceinline__ void operator()(const f32x4 (&acc)[2][2][4][2], const pg8::Unit& u, int wr, int wc, int fr, int fq) const {
        const int row0 = u.pm * 256 + wr * 64 + fr, col0 = u.pn * 128 + wc * 32 + 8 * fq; const __amdgpu_buffer_rsrc_t rs = ws_rsrc(ws);
#pragma unroll
        for (int ai = 0; ai < 2; ++ai)
#pragma unroll
            for (int m = 0; m < 4; ++m) { float o[8];
#pragma unroll
                for (int n = 0; n < 2; ++n)
#pragma unroll
                    for (int j = 0; j < 4; ++j) { const float gte = acc[ai][0][m][n][j], up = acc[ai][1][m][n][j]; o[4 * n + j] = gte * __builtin_amdgcn_rcpf(1.f + __expf(-gte)) * up; }
                u32x4 w; w.x = cvt_pk_bf16(o[0], o[1]); w.y = cvt_pk_bf16(o[2], o[3]); w.z = cvt_pk_bf16(o[4], o[5]); w.w = cvt_pk_bf16(o[6], o[7]);
                st16_wt(rs, WS_ACT + ((size_t)(row0 + ai * 128 + m * 16) * DFF + col0) * 2, w); }
    }
};

struct EpiAny {
    static constexpr bool PERM = true, AFTER_DRAIN = false;
    int mode; unsigned char* ws; const float* hin; float* hout; int gate_off; int gate1_off;
    __device__ __forceinline__ void operator()(const f32x4 (&acc)[2][2][4][2], const pg8::Unit& u, int wr, int wc, int fr, int fq) const {
        if (mode == 0) { EpiZ E{ws}; E(acc, u, wr, wc, fr, fq); }
        else if (mode == 1) { EpiRes E{hin, hout, ws, gate_off, gate1_off}; E(acc, u, wr, wc, fr, fq); }
        else if (mode == 3) { EpiDelta E{ws}; E(acc, u, wr, wc, fr, fq); }
        else { EpiSwiglu E{ws}; E(acc, u, wr, wc, fr, fq); }
    }
};

__device__ __forceinline__ void phase_attn(const Params& p, int l, float* lds) {
    const int tid = fresh_tid(), lane = tid & 63, wave = tid >> 6, fr = lane & 15, fq = lane >> 4;
    const float* rpb = p.in[I_RPB] + (size_t)l * 8 * 15 * 31;
    for (int i = tid; i < 8 * 15 * 31; i += 512) lds[i] = rpb[i];
    __syncthreads();
    const bf16_t* qk = (const bf16_t*)(p.ws + WS_QK); const bf16_t* vT = (const bf16_t*)(p.ws + WS_VT); bf16_t* ymix = (bf16_t*)(p.ws + WS_U);
    for (int task = blockIdx.x * 8 + wave; task < NB * 128 * 8 * 4; task += gridDim.x * 8) {
        const int g = task & 3, h = (task >> 2) & 7, i = (task >> 5) & 127, b = task >> 12;
        const int r0 = min(max(i - 4, 0), 120), c0 = g == 0 ? 0 : (g == 1 ? 8 : (g == 2 ? 24 : 32));
        const int qcol = 16 * g + fr, cs = min(max(qcol - 8, 0), 48);
        const size_t qtok = (size_t)b * SEQ + i * 64 + qcol;
        bf16x8 qf[2];
        qf[0] = *(const bf16x8*)(qk + qtok * 1024 + h * 64 + 8 * fq); qf[1] = *(const bf16x8*)(qk + qtok * 1024 + h * 64 + 32 + 8 * fq);
        const int kcolA = c0 + 8 * (fr >> 2) + (fr & 3);
        const bf16_t* kbase = qk + ((size_t)b * SEQ + r0 * 64 + kcolA) * 1024 + 512 + h * 64 + 8 * fq;
        const bf16_t* vbase = vT + ((size_t)(b * 8 + h) * 64 + fr) * SEQ + r0 * 64 + c0 + 8 * fq;
        bf16x8 kf[8][2][2];
#pragma unroll
        for (int kr = 0; kr < 8; ++kr)
#pragma unroll
            for (int blk = 0; blk < 2; ++blk) { const bf16_t* kp = kbase + (size_t)(kr * 64 + 4 * blk) * 1024; kf[kr][blk][0] = *(const bf16x8*)kp; kf[kr][blk][1] = *(const bf16x8*)(kp + 32); }
        __builtin_amdgcn_sched_barrier(0);
        float sc[8][8];
#pragma unroll
        for (int kr = 0; kr < 8; ++kr)
#pragma unroll
            for (int blk = 0; blk < 2; ++blk) {
                f32x4 a = {0.f, 0.f, 0.f, 0.f};
                a = __builtin_amdgcn_mfma_f32_16x16x32_bf16(kf[kr][blk][0], qf[0], a, 0, 0, 0);
                a = __builtin_amdgcn_mfma_f32_16x16x32_bf16(kf[kr][blk][1], qf[1], a, 0, 0, 0);
#pragma unroll
                for (int j = 0; j < 4; ++j) sc[kr][4 * blk + j] = a[j];
            }
        __builtin_amdgcn_sched_barrier(0);
        bf16x8 vfa[2][8];
#pragma unroll
        for (int db = 0; db < 2; ++db)
#pragma unroll
            for (int kr = 0; kr < 8; ++kr) vfa[db][kr] = *(const bf16x8*)(vbase + (size_t)(16 * db) * SEQ + kr * 64);
        __builtin_amdgcn_sched_barrier(0);
        float mx = -1e30f;
#pragma unroll
        for (int kr = 0; kr < 8; ++kr) { const int ro = r0 + kr - i + 7;
#pragma unroll
            for (int e = 0; e < 8; ++e) { const int kc = c0 + 8 * fq + e; const bool valid = (kc >= cs) && (kc < cs + 16); const int co = min(max(kc - qcol + 15, 0), 30);
                const float s = valid ? sc[kr][e] + lds[(h * 15 + ro) * 31 + co] : -1e30f; sc[kr][e] = s; mx = fmaxf(mx, s); } }
        mx = fmaxf(mx, __shfl_xor(mx, 16)); mx = fmaxf(mx, __shfl_xor(mx, 32));
        float sum = 0.f; bf16x8 pf[8];
#pragma unroll
        for (int kr = 0; kr < 8; ++kr) { float pe[8];
#pragma unroll
            for (int e = 0; e < 8; ++e) { pe[e] = __builtin_amdgcn_exp2f((sc[kr][e] - mx) * 1.4426950408889634f); sum += pe[e]; }
            u32x4 w; w.x = cvt_pk_bf16(pe[0], pe[1]); w.y = cvt_pk_bf16(pe[2], pe[3]); w.z = cvt_pk_bf16(pe[4], pe[5]); w.w = cvt_pk_bf16(pe[6], pe[7]);
            pf[kr] = __builtin_bit_cast(bf16x8, w); }
        sum += __shfl_xor(sum, 16); sum += __shfl_xor(sum, 32);
        const float inv = 1.f / sum;
        __builtin_amdgcn_sched_barrier(0);
        bf16x8 vfb[2][8];
#pragma unroll
        for (int db = 0; db < 2; ++db)
#pragma unroll
            for (int kr = 0; kr < 8; ++kr) vfb[db][kr] = *(const bf16x8*)(vbase + (size_t)(16 * (db + 2)) * SEQ + kr * 64);
        __builtin_amdgcn_sched_barrier(0);
        f32x4 o[4];
#pragma unroll
        for (int db = 0; db < 4; ++db) { o[db] = (f32x4){0.f, 0.f, 0.f, 0.f};
#pragma unroll
            for (int kr = 0; kr < 8; ++kr) o[db] = __builtin_amdgcn_mfma_f32_16x16x32_bf16(db < 2 ? vfa[db & 1][kr] : vfb[db & 1][kr], pf[kr], o[db], 0, 0, 0); }
        asm volatile("s_waitcnt vmcnt(0)" ::: "memory");
#pragma unroll
        for (int db = 0; db < 4; ++db) { u32x2 w; w.x = cvt_pk_bf16(o[db][0] * inv, o[db][1] * inv); w.y = cvt_pk_bf16(o[db][2] * inv, o[db][3] * inv);
            *(u32x2*)(ymix + qtok * 1024 + 512 + h * 64 + 16 * db + 4 * fq) = w; }
    }
}

constexpr int PT = 32, PSTR = 392;
constexpr int PC_OFF = 6400;
__device__ __forceinline__ float fast_tanh(float x) { return 1.f - 2.f * __builtin_amdgcn_rcpf(1.f + __expf(2.f * x)); }
__device__ __forceinline__ void phase_prep(const Params& p, int l, float* ldsf) {
    const int tid = fresh_tid(), wave = __builtin_amdgcn_readfirstlane(tid >> 6);
    bf16_t* lact = (bf16_t*)ldsf;
    float* cmu0 = ldsf + PC_OFF; float* cmu1 = cmu0 + 1920; float* ckk = cmu1 + 1920; float* cka = ckk + 512; float* crk = cka + 512; float* cw0 = crk + 512; float* ca0 = cw0 + 1024;
    const bf16_t* zr = (const bf16_t*)(p.ws + WS_ZR); const bf16_t* WL = (const bf16_t*)(p.ws + WS_WL);
    bf16_t* R = (bf16_t*)(p.ws + WS_R); bf16_t* K = (bf16_t*)(p.ws + WS_K); bf16_t* V = (bf16_t*)(p.ws + WS_V);
    bf16_t* ymix = (bf16_t*)(p.ws + WS_U); float* coef = (float*)(p.ws + WS_COEF); float* rstdp = (float*)(p.ws + WS_RSTD);
    for (int i = tid; i < 3840; i += 512) cmu0[i] = p.in[I_MU][(size_t)l * 3840 + i];
    for (int i = tid; i < 512; i += 512) { ckk[i] = p.in[I_KK][l * RW + i]; cka[i] = p.in[I_KA][l * RW + i]; crk[i] = p.in[I_RK][l * RW + i]; }
    for (int i = tid; i < 1024; i += 512) { cw0[i] = p.in[I_W0][l * 1024 + i]; ca0[i] = p.in[I_A0][l * 1024 + i]; }
    __syncthreads();
    unsigned zc1[12], zp1[12], zn1[12];
#define PREP_S1_LOAD(TILE) do { int t_ = tid; asm volatile("" : "+v"(t_)); \
        _Pragma("unroll") for (int i = 0; i < 12; ++i) { const int idx = t_ + 512 * i, tt = idx / 192, c2 = idx - tt * 192; \
            const bf16_t* zc_p = zr + (size_t)((TILE) * PT + tt) * 2048 + 1536 + 2 * c2; \
            zc1[i] = *(const unsigned*)(zc_p); zp1[i] = *(const unsigned*)(zc_p - 2048); zn1[i] = *(const unsigned*)(zc_p + 2048); } } while (0)
    if ((int)blockIdx.x < MTOK / PT) PREP_S1_LOAD(blockIdx.x);
    for (int tile = blockIdx.x; tile < MTOK / PT; tile += gridDim.x) {
        const int m0 = tile * PT;
        int lane = tid & 63; asm volatile("" : "+v"(lane));
        const int fr = lane & 15, fq = lane >> 4;
        asm volatile("s_waitcnt vmcnt(0)" ::: "memory");
        { int t_ = tid; asm volatile("" : "+v"(t_));
#pragma unroll
        for (int i = 0; i < 12; ++i) { const int idx = t_ + 512 * i, tt = idx / 192, c2 = idx - tt * 192, m = m0 + tt, t = m & 8191, col = 1536 + 2 * c2;
            const unsigned zc = zc1[i], zp = zp1[i], zn = zn1[i];
            const float pmask = t == 0 ? 0.f : 1.f, nmask = t == SEQ - 1 ? 0.f : 1.f;
            const float2 m0v = *(const float2*)(cmu0 + col), m1v = *(const float2*)(cmu1 + col);
            float v0 = bflo(zc) + m0v.x * (bflo(zp) * pmask - bflo(zc)) + m1v.x * (bflo(zn) * nmask - bflo(zc));
            float v1 = bfhi(zc) + m0v.y * (bfhi(zp) * pmask - bfhi(zc)) + m1v.y * (bfhi(zn) * nmask - bfhi(zc));
            if (c2 < 64) { v0 = fast_tanh(v0); v1 = fast_tanh(v1); } else if (c2 >= 128) { v0 = sigmoidf_(v0); v1 = sigmoidf_(v1); }
            *(unsigned*)(lact + tt * PSTR + 2 * c2) = cvt_pk_bf16(v0, v1); } }
        if (tile + (int)gridDim.x < MTOK / PT) PREP_S1_LOAD(tile + gridDim.x);
        __syncthreads();
        f32x4 asum[2][4];
        const bf16_t* wlb = WL + (size_t)(64 * wave + 8 * (fr >> 2) + (fr & 3)) * 384 + 8 * fq;
#pragma unroll
        for (int o = 0; o < 5; ++o) {
            f32x4 acc[2][4];
#pragma unroll
            for (int mb = 0; mb < 2; ++mb)
#pragma unroll
                for (int nb = 0; nb < 4; ++nb) acc[mb][nb] = (f32x4){0.f, 0.f, 0.f, 0.f};
            const int ks0 = o < 4 ? 2 * o : 8;
            bf16x8 wf[4][4];
#pragma unroll
            for (int kk = 0; kk < 4; ++kk)
#pragma unroll
                for (int nb = 0; nb < 4; ++nb) if (kk < (o < 4 ? 2 : 4)) wf[kk][nb] = *(const bf16x8*)(wlb + (size_t)(32 * (nb >> 1) + 4 * (nb & 1)) * 384 + 32 * (ks0 + kk));
            __builtin_amdgcn_sched_barrier(0);
            asm volatile("s_waitcnt vmcnt(0)" ::: "memory");
#pragma unroll
            for (int kk = 0; kk < 4; ++kk) if (kk < (o < 4 ? 2 : 4)) { const int ks = ks0 + kk;
                bf16x8 af[2];
#pragma unroll
                for (int mb = 0; mb < 2; ++mb) af[mb] = *(const bf16x8*)(lact + (16 * mb + fr) * PSTR + 32 * ks + 8 * fq);
#pragma unroll
                for (int mb = 0; mb < 2; ++mb)
#pragma unroll
                    for (int nb = 0; nb < 4; ++nb) acc[mb][nb] = __builtin_amdgcn_mfma_f32_16x16x32_bf16(wf[kk][nb], af[mb], acc[mb][nb], 0, 0, 0);
            }
#pragma unroll
            for (int np = 0; np < 2; ++np) { const int col = 64 * wave + 32 * np + 8 * fq;
                f32x4 bias0 = {0.f, 0.f, 0.f, 0.f}, bias1 = {0.f, 0.f, 0.f, 0.f};
                if (o < 2) { bias0 = *(const f32x4*)(cw0 + o * RW + col); bias1 = *(const f32x4*)(cw0 + o * RW + col + 4); }
                else if (o < 4) { bias0 = *(const f32x4*)(ca0 + (o - 2) * RW + col); bias1 = *(const f32x4*)(ca0 + (o - 2) * RW + col + 4); }
#pragma unroll
                for (int mb = 0; mb < 2; ++mb) { const size_t m = (size_t)(m0 + 16 * mb + fr); f32x4 v0 = acc[mb][2 * np] + bias0, v1 = acc[mb][2 * np + 1] + bias1;
                    if (o < 4) {
#pragma unroll
                        for (int j = 0; j < 4; ++j) { v0[j] = sigmoidf_(v0[j]); v1[j] = sigmoidf_(v1[j]); }
                        if (o < 2) { v0 = v0 * 0.6065306597126334f; v1 = v1 * 0.6065306597126334f; }
                        else if (o == 2) { asum[mb][2 * np] = v0; asum[mb][2 * np + 1] = v1; } else { asum[mb][2 * np] += v0; asum[mb][2 * np + 1] += v1; } }
                    u32x4 w; w.x = cvt_pk_bf16(v0[0], v0[1]); w.y = cvt_pk_bf16(v0[2], v0[3]); w.z = cvt_pk_bf16(v1[0], v1[1]); w.w = cvt_pk_bf16(v1[2], v1[3]);
                    bf16_t* dst = o == 4 ? ymix + m * 1024 + col : (bf16_t*)(p.ws + (o == 0 ? WS_E0 : (o == 1 ? WS_E1 : (o == 2 ? WS_A0 : WS_A1)))) + m * RW + col;
                    *(u32x4*)dst = w; }
            }
            __builtin_amdgcn_sched_barrier(0);
        }
#pragma unroll
        for (int mb = 0; mb < 2; ++mb) { const int m = m0 + 16 * mb + fr, t = m & 8191; float ssq = 0.f, cf = 0.f;
            const int lc = 64 * wave + 8 * fq;
            const bf16_t* zc_p = zr + (size_t)m * 2048 + lc; const bf16_t* zp_p = zc_p - 2048; const bf16_t* zn_p = zc_p + 2048;
            const float pmask = t == 0 ? 0.f : 1.f, nmask = t == SEQ - 1 ? 0.f : 1.f;
            bf16_t* Rp = R + (size_t)m * RW + lc; bf16_t* Kp = K + (size_t)m * RW + lc; bf16_t* Vp = V + (size_t)m * RW + lc;
            u32x4 zcv[2][3], zpv[2][3], znv[2][3];
#pragma unroll
            for (int np = 0; np < 2; ++np)
#pragma unroll
                for (int part = 0; part < 3; ++part) { const int co = part * 512 + 32 * np; zcv[np][part] = *(const u32x4*)(zc_p + co); zpv[np][part] = *(const u32x4*)(zp_p + co); znv[np][part] = *(const u32x4*)(zn_p + co); }
            __builtin_amdgcn_sched_barrier(0);
            asm volatile("s_waitcnt vmcnt(0)" ::: "memory");
#pragma unroll
            for (int np = 0; np < 2; ++np) { float rr[8], kx[8];
#pragma unroll
                for (int part = 0; part < 3; ++part) { const int co = part * 512 + 32 * np;
                    const u32x4 zc = zcv[np][part], zp = zpv[np][part], zn = znv[np][part];
                    float o8[8];
#pragma unroll
                    for (int hf = 0; hf < 2; ++hf) { const f32x4 m0v = *(const f32x4*)(cmu0 + lc + co + 4 * hf), m1v = *(const f32x4*)(cmu1 + lc + co + 4 * hf);
                        const unsigned c0_ = hf ? zc.z : zc.x, c1_ = hf ? zc.w : zc.y, p0_ = hf ? zp.z : zp.x, p1_ = hf ? zp.w : zp.y, n0_ = hf ? zn.z : zn.x, n1_ = hf ? zn.w : zn.y;
                        float c4[4] = {bflo(c0_), bfhi(c0_), bflo(c1_), bfhi(c1_)}, p4[4] = {bflo(p0_), bfhi(p0_), bflo(p1_), bfhi(p1_)}, n4[4] = {bflo(n0_), bfhi(n0_), bflo(n1_), bfhi(n1_)};
#pragma unroll
                        for (int j = 0; j < 4; ++j) o8[4 * hf + j] = c4[j] + m0v[j] * (p4[j] * pmask - c4[j]) + m1v[j] * (n4[j] * nmask - c4[j]); }
                    u32x4 w; w.x = cvt_pk_bf16(o8[0], o8[1]); w.y = cvt_pk_bf16(o8[2], o8[3]); w.z = cvt_pk_bf16(o8[4], o8[5]); w.w = cvt_pk_bf16(o8[6], o8[7]);
                    *(u32x4*)((part == 0 ? Rp : (part == 1 ? Kp : Vp)) + 32 * np) = w;
                    if (part == 0) {
#pragma unroll
                        for (int e = 0; e < 8; ++e) rr[e] = o8[e]; }
                    if (part == 1) {
#pragma unroll
                        for (int e = 0; e < 8; ++e) kx[e] = o8[e]; }
                }
#pragma unroll
                for (int hf = 0; hf < 2; ++hf) { const f32x4 kk4 = *(const f32x4*)(ckk + lc + 32 * np + 4 * hf), ka4 = *(const f32x4*)(cka + lc + 32 * np + 4 * hf), rk4 = *(const f32x4*)(crk + lc + 32 * np + 4 * hf);
#pragma unroll
                    for (int j = 0; j < 4; ++j) { const float kq = kx[4 * hf + j] * kk4[j]; ssq += kq * kq; cf += rr[4 * hf + j] * kx[4 * hf + j] * (2.f + (asum[mb][2 * np + hf][j] - 2.f) * ka4[j]) * rk4[j]; } }
            }
            ssq += __shfl_xor(ssq, 16); ssq += __shfl_xor(ssq, 32); cf += __shfl_xor(cf, 16); cf += __shfl_xor(cf, 32);
            if (fq == 0) { rstdp[(size_t)m * 8 + wave] = 1.f / fmaxf(sqrtf(ssq), 1e-12f); coef[(size_t)m * 8 + wave] = cf; }
            __builtin_amdgcn_sched_barrier(0);
        }
        __syncthreads();
    }
}

constexpr int ST = 32, SSTR = 336;
constexpr int YP_OFF = 2 * ST * SSTR;
typedef float f32x2_t __attribute__((ext_vector_type(2)));
#define SCAN_LOAD(CH, RW_, KW_, EW_, AW_, RS_, VW_) do { \
    _Pragma("unroll") for (int i = 0; i < 4; ++i) { const int tt = sg + 8 * i, s_ = (CH) * ST + tt, t_ = d ? SEQ - 1 - s_ : s_; const size_t m_ = (size_t)b * SEQ + t_; \
        RW_[i] = *(const unsigned*)(R + m_ * RW + h * 64 + 2 * j2); KW_[i] = *(const unsigned*)(K + m_ * RW + h * 64 + 2 * j2); \
        EW_[i] = *(const unsigned*)(E + m_ * RW + h * 64 + 2 * j2); AW_[i] = *(const unsigned*)(A + m_ * RW + h * 64 + 2 * j2); RS_[i] = rstdp[m_ * 8 + h]; } \
    { const int s_ = (CH) * ST + tv, t_ = d ? SEQ - 1 - s_ : s_; const size_t m_ = (size_t)b * SEQ + t_; VW_ = *(const unsigned*)(V + m_ * RW + h * 64 + 16 * rg + 2 * vi2); } } while (0)
__device__ __forceinline__ void phase_scan(const Params& p, int l, float* lds) {
    const int tid = fresh_tid(), lane = tid & 63, wave = tid >> 6;
    const bf16_t* R = (const bf16_t*)(p.ws + WS_R); const bf16_t* K = (const bf16_t*)(p.ws + WS_K); const bf16_t* V = (const bf16_t*)(p.ws + WS_V);
    const float* rstdp = (const float*)(p.ws + WS_RSTD);
    constexpr int NCH = SEQ / ST;
    for (int item = blockIdx.x; item < 256; item += gridDim.x) {
        const int chain = (item & 7) + 8 * (item >> 5), rg = (item >> 3) & 3, d = chain >> 5, b = (chain >> 3) & 3, h = chain & 7;
        const bf16_t* E = (const bf16_t*)(p.ws + (d ? WS_E1 : WS_E0)); const bf16_t* A = (const bf16_t*)(p.ws + (d ? WS_A1 : WS_A0));
        float* ydir = (float*)(p.ws + WS_ZR) + (size_t)d * MTOK * RW;
        if (wave >= 4) {
            const int lt = tid - 256, j2 = lt & 31, sg = lt >> 5, tv = lt >> 3, vi2 = lt & 7;
            const float kk0 = p.in[I_KK][l * RW + h * 64 + 2 * j2], kk1 = p.in[I_KK][l * RW + h * 64 + 2 * j2 + 1];
            const float ka0 = p.in[I_KA][l * RW + h * 64 + 2 * j2], ka1 = p.in[I_KA][l * RW + h * 64 + 2 * j2 + 1];
            unsigned rwA[4], kwA[4], ewA[4], awA[4], vwA; float rsA[4];
            SCAN_LOAD(0, rwA, kwA, ewA, awA, rsA, vwA);
            for (int ch = 0; ch < NCH + 2; ++ch) {
                asm volatile("s_waitcnt vmcnt(0)" ::: "memory");
                if (ch < NCH) {
                    float* buf = lds + (ch & 1) * ST * SSTR;
#pragma unroll
                    for (int i = 0; i < 4; ++i) { const int tt = sg + 8 * i;
                        const float k0 = bflo(kwA[i]), k1 = bfhi(kwA[i]), a0 = bflo(awA[i]), a1 = bfhi(awA[i]);
                        const float q0 = k0 * kk0 * rsA[i], q1 = k1 * kk1 * rsA[i];
                        float* bp = buf + tt * SSTR + 2 * j2;
                        *(float2*)(bp) = make_float2(__expf(-bflo(ewA[i])), __expf(-bfhi(ewA[i])));
                        *(float2*)(bp + 64) = make_float2(k0 * (1.f + (a0 - 1.f) * ka0), k1 * (1.f + (a1 - 1.f) * ka1));
                        *(float2*)(bp + 128) = make_float2(q0 * a0, q1 * a1);
                        *(float2*)(bp + 192) = make_float2(q0, q1);
                        *(float2*)(bp + 256) = make_float2(bflo(rwA[i]), bfhi(rwA[i])); }
                    *(float2*)(buf + tv * SSTR + 320 + 2 * vi2) = make_float2(bflo(vwA), bfhi(vwA));
                }
                if (ch >= 2) {
                    const float* yp = lds + YP_OFF + (((ch & 1) * ST + tv) * 16 + 2 * vi2) * 8;
                    const int rot = (lt >> 2) & 3; float ya = 0.f, yb = 0.f;
#pragma unroll
                    for (int e = 0; e < 4; ++e) { const int c = (e + rot) & 3; const f32x4 pv = *(const f32x4*)(yp + 4 * c); const float sv = (pv[0] + pv[1]) + (pv[2] + pv[3]);
                        ya += c < 2 ? sv : 0.f; yb += c < 2 ? 0.f : sv; }
                    const int s_ = (ch - 2) * ST + tv, t_ = d ? SEQ - 1 - s_ : s_;
                    *(float2*)(ydir + ((size_t)b * SEQ + t_) * RW + h * 64 + 16 * rg + 2 * vi2) = make_float2(ya, yb);
                }
                if (ch + 1 < NCH) SCAN_LOAD(ch + 1, rwA, kwA, ewA, awA, rsA, vwA);
                __syncthreads();
            }
        } else {
            const int cgp = lane >> 4, q = lane & 15;
            f32x2_t s01 = {0.f, 0.f}, s23 = {0.f, 0.f};
            for (int ch = 0; ch < NCH + 2; ++ch) {
                if (ch >= 1 && ch <= NCH) {
                    const float* buf = lds + ((ch - 1) & 1) * ST * SSTR;
                    float* ypw = lds + YP_OFF + ((((ch - 1) & 1) * ST) * 16 + 4 * wave + cgp) * 8 + (q & 7);
                    const float* bq = buf + 4 * q; const float* bvp = buf + 320 + 4 * wave + cgp;
                    f32x4 w4 = *(const f32x4*)(bq), kd = *(const f32x4*)(bq + 64), bv = *(const f32x4*)(bq + 128), kk = *(const f32x4*)(bq + 192), r4 = *(const f32x4*)(bq + 256);
                    float vv = bvp[0];
                    f32x4 w4n = *(const f32x4*)(bq + SSTR), kdn = *(const f32x4*)(bq + SSTR + 64), bvn = *(const f32x4*)(bq + SSTR + 128), kkn = *(const f32x4*)(bq + SSTR + 192), r4n = *(const f32x4*)(bq + SSTR + 256);
                    float vvn = bvp[SSTR];
#pragma unroll
                    for (int tt = 0; tt < ST; ++tt) {
                        const int tn = tt + 2 < ST ? tt + 2 : ST - 1; const float* nb = bq + tn * SSTR;
                        const f32x4 w4m = *(const f32x4*)(nb), kdm = *(const f32x4*)(nb + 64), bvm = *(const f32x4*)(nb + 128), kkm = *(const f32x4*)(nb + 192), r4m = *(const f32x4*)(nb + 256);
                        const float vvm = bvp[tn * SSTR];
                        f32x2_t p2 = s01 * kk.xy; p2 = s23 * kk.zw + p2;
                        float pp = p2.x + p2.y;
                        pp = rowsum16(pp);
                        const f32x2_t vv2 = {vv, vv}, npp = {-pp, -pp};
                        f32x2_t t01 = s01 * w4.xy + vv2 * kd.xy, t23 = s23 * w4.zw + vv2 * kd.zw;
                        s01 = npp * bv.xy + t01; s23 = npp * bv.zw + t23;
                        f32x2_t q2 = s01 * r4.xy; q2 = s23 * r4.zw + q2;
                        float yq = q2.x + q2.y;
                        yq += dppf<0x128>(yq);
                        ypw[tt * 128] = yq;
                        w4 = w4n; kd = kdn; bv = bvn; kk = kkn; r4 = r4n; vv = vvn;
                        w4n = w4m; kdn = kdm; bvn = bvm; kkn = kkm; r4n = r4m; vvn = vvm;
                    }
                }
                __syncthreads();
            }
        }
        __syncthreads();
    }
}

__device__ __forceinline__ void phase_post(const Params& p, int l) {
    const int tid = fresh_tid(), lane = tid & 63, wave = tid >> 6, c = 8 * lane, hd = lane >> 3;
    const float* y0 = (const float*)(p.ws + WS_ZR); const float* y1 = y0 + (size_t)MTOK * RW;
    const bf16_t* V = (const bf16_t*)(p.ws + WS_V); const float* coef = (const float*)(p.ws + WS_COEF); bf16_t* ymix = (bf16_t*)(p.ws + WS_U);
    float lg[8], lb[8];
#pragma unroll
    for (int e = 0; e < 8; ++e) { lg[e] = p.in[I_LNG][l * RW + c + e]; lb[e] = p.in[I_LNB][l * RW + c + e]; }
    const int stride = gridDim.x * 8; const __amdgpu_buffer_rsrc_t wsr = ws_rsrc(p.ws);
    for (int mA = blockIdx.x * 8 + wave; mA < MTOK; mA += 2 * stride) {
        const int mB = mA + stride < MTOK ? mA + stride : mA;
        f32x4 ya[2][2], yb[2][2]; u32x4 vw[2], gw[2]; float cf[2];
#pragma unroll
        for (int r = 0; r < 2; ++r) { const size_t m = (size_t)(r ? mB : mA);
            ya[r][0] = __builtin_nontemporal_load((const f32x4*)(y0 + m * RW + c)); ya[r][1] = __builtin_nontemporal_load((const f32x4*)(y0 + m * RW + c + 4)); yb[r][0] = __builtin_nontemporal_load((const f32x4*)(y1 + m * RW + c)); yb[r][1] = __builtin_nontemporal_load((const f32x4*)(y1 + m * RW + c + 4));
            vw[r] = *(const u32x4*)(V + m * RW + c); gw[r] = *(const u32x4*)(ymix + m * 1024 + c); cf[r] = coef[m * 8 + hd]; }
        asm volatile("s_waitcnt vmcnt(0)" ::: "memory");
#pragma unroll
        for (int r = 0; r < 2; ++r) { const size_t m = (size_t)(r ? mB : mA);
            float y[8];
#pragma unroll
            for (int e = 0; e < 4; ++e) { y[e] = ya[r][0][e] + yb[r][0][e]; y[4 + e] = ya[r][1][e] + yb[r][1][e]; }
            float s1 = 0.f;
#pragma unroll
            for (int e = 0; e < 8; ++e) s1 += y[e];
            s1 += __shfl_xor(s1, 1); s1 += __shfl_xor(s1, 2); s1 += __shfl_xor(s1, 4);
            const float mean = s1 * (1.f / 64.f);
            float s2 = 0.f;
#pragma unroll
            for (int e = 0; e < 8; ++e) { y[e] -= mean; s2 += y[e] * y[e]; }
            s2 += __shfl_xor(s2, 1); s2 += __shfl_xor(s2, 2); s2 += __shfl_xor(s2, 4);
            const float rs = rsqrtf(s2 * (1.f / 64.f) + 64e-5f);
            float o[8];
#pragma unroll
            for (int e = 0; e < 4; ++e) { const unsigned vv = vw[r][e], gg = gw[r][e];
                o[2 * e] = (y[2 * e] * rs * lg[2 * e] + lb[2 * e] + cf[r] * bflo(vv)) * bflo(gg);
                o[2 * e + 1] = (y[2 * e + 1] * rs * lg[2 * e + 1] + lb[2 * e + 1] + cf[r] * bfhi(vv)) * bfhi(gg); }
            u32x4 w; w.x = cvt_pk_bf16(o[0], o[1]); w.y = cvt_pk_bf16(o[2], o[3]); w.z = cvt_pk_bf16(o[4], o[5]); w.w = cvt_pk_bf16(o[6], o[7]);
            if (r == 0 || mB != mA) st16_wt(wsr, WS_U + (m * 1024 + c) * 2, w);
        }
    }
}

__device__ __forceinline__ void fast_grid_barrier(unsigned* bar, unsigned k) {
    asm volatile("s_waitcnt vmcnt(0)" ::: "memory");
    __syncthreads();
    if (threadIdx.x == 0) {
        const unsigned G = gridDim.x, g = blockIdx.x & 7u, ng = G < 8u ? G : 8u, gsz = (G + 7u - g) >> 3;
        __builtin_amdgcn_fence(__ATOMIC_RELEASE, "agent");
        asm volatile("s_waitcnt vmcnt(0)" ::: "memory");
        const unsigned old = __hip_atomic_fetch_add(bar + 64 * (g + 1), 1u, __ATOMIC_RELAXED, __HIP_MEMORY_SCOPE_AGENT);
        if (old + 1u == k * gsz) __hip_atomic_fetch_add(bar, 1u, __ATOMIC_RELAXED, __HIP_MEMORY_SCOPE_AGENT);
        unsigned spins = 0;
        while (__hip_atomic_load(bar, __ATOMIC_RELAXED, __HIP_MEMORY_SCOPE_AGENT) < k * ng) { __builtin_amdgcn_s_sleep(1); if (++spins > (1u << 22)) break; }
        __builtin_amdgcn_fence(__ATOMIC_ACQUIRE, "agent");
        asm volatile("s_waitcnt vmcnt(0)" ::: "memory");
    }
    __syncthreads();
}

#ifndef GA
#define GA true
#endif
#ifndef GS
#define GS true
#endif
#ifndef PROBE_S
#define PROBE_S -1
#endif
#ifndef PHM
#define PHM 0xFFFF
#endif
#ifndef ONE_LAUNCH
#define ONE_LAUNCH 1
#endif
__global__ void __launch_bounds__(512, 2) hybrid_fwd(Params p_) {
    extern __shared__ __attribute__((aligned(16))) unsigned char lds_raw[];
    float* ldsf = (float*)lds_raw;
    LAS unsigned char* ldsa = (LAS unsigned char*)lds_raw;
    const int G = gridDim.x, bx = blockIdx.x;
    const int ph_lo = p_.lo, ph_hi = p_.hi;
    for (int ph = ph_lo; ph < ph_hi; ++ph) {
        typedef const __attribute__((address_space(4))) Params* kparg_t;
        kparg_t pp = (kparg_t)__builtin_amdgcn_kernarg_segment_ptr();
        asm volatile("" : "+s"(pp));
        Params p;
#pragma unroll
        for (int i = 0; i < 24; ++i) p.in[i] = pp->in[i];
        p.out = pp->out; p.ws = pp->ws; p.lo = ph_lo; p.hi = ph_hi;
        if (ph == 0) { if (blockIdx.x == 0 && threadIdx.x < 9) ((unsigned*)(p.ws + WS_BAR))[64 * threadIdx.x] = 0u;
            if (PHM & 0x400) phase_mod(p, ldsf); __syncthreads(); phase_conv(p, 0, ldsf); }
        else {
            const int l = (ph - 1) / 10, s = (ph - 1) % 10;
            for (int rep = 0; rep < (s == PROBE_S ? 2 : 1); ++rep) {
            if (rep) __syncthreads();
            if (s == 1 || s == 6 || s == 8 || s == 9) {
                if (PHM & 2) {
                const int mode = s == 1 ? 0 : (s == 8 ? 2 : (s == 6 ? 3 : 1));
                const size_t aoff = s == 9 ? WS_ACT : WS_U, boff = s == 1 ? WS_W1 : (s == 6 ? WS_W2 : (s == 8 ? WS_W3 : WS_W4));
                const int N = s == 1 ? NPAD1 : (s == 8 ? 2 * DFF : DM), K = s == 9 ? DFF : DM;
                pg8::Gemm g{(const bf16_t*)(p.ws + aoff), (const bf16_t*)(p.ws + boff), MTOK, N, K}; pg8::StaticOrder S; S.init(MTOK, N, G, bx);
                EpiAny E{mode, p.ws, l == 0 ? p.in[I_X] : p.out, p.out, l * NB * 6144 + 5 * DM, l * NB * 6144 + 2 * DM};
                pg8::gemm_phase<EpiAny, pg8::StaticOrder, GA, GS>(ldsa, g, S, E);
                }
            } else switch (s) {
            case 0: if (PHM & 1) { if (l > 0) phase_conv(p, l, ldsf); __syncthreads(); phase_norm(p, l, 0, l == 0 ? p.in[I_X] : p.out, ldsf); } break;
            case 2: if (PHM & 4) phase_attn(p, l, ldsf); break;
            case 3: if (PHM & 8) phase_prep(p, l, ldsf); break;
            case 4: if (PHM & 16) phase_scan(p, l, ldsf); break;
            case 5: if (PHM & 32) phase_post(p, l); break;
            case 7: if (PHM & 128) phase_norm(p, l, 1, l == 0 ? p.in[I_X] : p.out, ldsf); break;
            }
            }
        }
        __syncthreads();
#if ONE_LAUNCH
        if (ph + 1 < ph_hi) { if (ph == 0) cg::this_grid().sync(); else fast_grid_barrier((unsigned*)(p.ws + WS_BAR), (unsigned)ph); }
#endif
    }
}

extern "C" void kernel_launch(void* const* d_in, const int* in_sizes, int n_in, void* d_out, int out_size, void* d_ws, size_t ws_size, hipStream_t stream) {
    static int grid = 0;
    if (grid == 0) {
        if (n_in != 24 || out_size != MTOK * DM || ws_size < WS_END) { fprintf(stderr, "kernel_launch: unexpected shapes / workspace (n_in %d, out %d, ws %zu)\n", n_in, out_size, ws_size); grid = -1; return; }
        int dev = 0, cus = 0;
        if (hipGetDevice(&dev) != hipSuccess || hipDeviceGetAttribute(&cus, hipDeviceAttributeMultiprocessorCount, dev) != hipSuccess) { grid = -1; return; }
        if (hipFuncSetAttribute((const void*)hybrid_fwd, hipFuncAttributeMaxDynamicSharedMemorySize, LDS_BYTES) != hipSuccess) { grid = -1; return; }
        grid = cus;
    }
    if (grid < 0) return;
    Params p{};
    for (int i = 0; i < 24; ++i) p.in[i] = (const float*)d_in[i];
    p.out = (float*)d_out; p.ws = (unsigned char*)d_ws;
#if ONE_LAUNCH
    p.lo = 0; p.hi = NPHASE;
    void* args[] = {&p};
    hipError_t e = hipLaunchCooperativeKernel((const void*)hybrid_fwd, dim3(grid), dim3(512), args, LDS_BYTES, stream);
    if (e != hipSuccess) fprintf(stderr, "cooperative launch failed: %s (grid %d)\n", hipGetErrorString(e), grid);
#else
    for (int ph = 0; ph < NPHASE; ++ph) { p.lo = ph; p.hi = ph + 1; hipLaunchKernelGGL(hybrid_fwd, dim3(grid), dim3(512), LDS_BYTES, stream, p); }
#endif
}
```

```cpp
#include <hip/hip_runtime.h>
#include <hip/hip_cooperative_groups.h>
#include <cstdio>
#include <cstdint>
__device__ __forceinline__ int fresh_tid() { int t = threadIdx.x; asm volatile("" : "+v"(t)); return t; }
namespace pg8 {
#define PG8_LAS __attribute__((address_space(3)))
typedef unsigned short bf16_t;
typedef short bf16x8 __attribute__((ext_vector_type(8)));
typedef float f32x4 __attribute__((ext_vector_type(4)));
typedef unsigned u32x4 __attribute__((ext_vector_type(4)));
constexpr int BM = 256, BK = 64, HALF = 128, HTB = HALF * BK * 2  , STAGE_BYTES = 8 * HTB, NXCD = 8, WGM = 4;

__host__ __device__ __forceinline__ int lds_byte(int r, int c) { const int st = (r >> 4) * 2 + (c >> 5), rr = r & 15, cc = c & 31, ob = rr * 64 + cc * 2; return st * 1024 + (ob ^ (((ob >> 9) & 1) << 5)); }
__host__ __device__ __forceinline__ void stage_rc(int b, int& R, int& C) { const int st = b / 1024, sb = b % 1024, swz = sb ^ (((sb >> 9) & 1) << 5); R = (st >> 1) * 16 + swz / 64; C = (st & 1) * 32 + (swz % 64) / 2; }
__host__ __device__ __forceinline__ int perm32(int rho) { const int n = rho >> 4, i = rho & 15; return 8 * (i >> 2) + 4 * n + (i & 3); }

struct Unit { int pm, pn; };
struct Gemm { const bf16_t* A; const bf16_t* Bt; int M, N, K; };

struct StaticOrder {
    int nM, nN, nwg, G, c;
    __host__ __device__ void init(int M, int N, int G_, int c_) { nM = M / BM; nN = N / BM; nwg = nM * nN; G = G_; c = c_; }
    __host__ __device__ bool next(int i, Unit& u) const {
        const long L = (long)i * G + c; if (L >= nwg) return false;
        int wgid = (int)L; { const int q = nwg / NXCD, r = nwg % NXCD, xcd = wgid % NXCD, off = wgid / NXCD; wgid = (xcd < r ? xcd * (q + 1) : r * (q + 1) + (xcd - r) * q) + off; }
        const int nig = WGM * nN, gid = wgid / nig, fm = gid * WGM, gsz = (nM - fm) < WGM ? (nM - fm) : WGM;
        u.pm = fm + ((wgid % nig) % gsz); u.pn = (wgid % nig) / gsz; return true;
    }
    __device__ __forceinline__ void a_ready(const Unit&) const {}
    __device__ __forceinline__ void done(const Unit&) const {}
};

typedef float f32x2c_t __attribute__((ext_vector_type(2))); typedef __bf16 bf16x2c_t __attribute__((ext_vector_type(2)));
__device__ __forceinline__ unsigned cvt_pk_bf16(float lo, float hi) { f32x2c_t v = {lo, hi}; bf16x2c_t b = __builtin_convertvector(v, bf16x2c_t); return __builtin_bit_cast(unsigned, b); }
typedef float f32x2 __attribute__((ext_vector_type(2)));
template <class Epi, class Sched, bool ALIGN_EPI = false, bool SP2 = false>
__device__ __forceinline__ void gemm_phase(PG8_LAS unsigned char* lds, const Gemm g, const Sched& S, const Epi& E) {
    const int tid = ::fresh_tid(), wid = __builtin_amdgcn_readfirstlane(tid >> 6), lane = tid & 63, wr = wid >> 2, wc = wid & 3, fr = lane & 15, fq = lane >> 4;
    const int K = g.K, nt = K / BK;
    unsigned voffA[2], voffB[2];
#pragma unroll
    for (int i = 0; i < 2; ++i) { int R, C; stage_rc(tid * 16 + i * 8192, R, C); const int Rb = Epi::PERM ? ((R & ~31) + perm32(R & 31)) : R;
        voffA[i] = (unsigned)(R * K + C) * 2u; voffB[i] = (unsigned)(Rb * K + C) * 2u; }
    const size_t kstep = (size_t)(BK * 2);
    const size_t hstep = (size_t)HALF * K * 2;
    const size_t tstep = 2 * hstep;
    const unsigned ldsw = (unsigned)wid * 1024u;
    const int aoff = lds_byte(wr * 64 + fr, fq * 8), boff = lds_byte(wc * 32 + fr, fq * 8);
#define PG8_SA(b, h) (((b) * 2 + (h)) * HTB)
#define PG8_SB(b, h) ((4 + (b) * 2 + (h)) * HTB)
#define PG8_STAGE(bufoff, gbase, voff) do { _Pragma("unroll") for (int _i = 0; _i < 2; ++_i) \
        __builtin_amdgcn_global_load_lds((const unsigned*)((const char*)(gbase) + (voff)[_i]), (PG8_LAS unsigned*)(lds + (bufoff) + ldsw + _i * 8192), 16, 0, 0); } while (0)
#define PG8_LDA(dst, b, h) do { _Pragma("unroll") for (int m = 0; m < 4; ++m) _Pragma("unroll") for (int k = 0; k < 2; ++k) dst[m][k] = *(const PG8_LAS bf16x8*)(lds + PG8_SA(b, h) + aoff + m * 2048 + k * 1024); } while (0)
#define PG8_LDB(dst, b, h) do { _Pragma("unroll") for (int n = 0; n < 2; ++n) _Pragma("unroll") for (int k = 0; k < 2; ++k) dst[n][k] = *(const PG8_LAS bf16x8*)(lds + PG8_SB(b, h) + boff + n * 2048 + k * 1024); } while (0)
#define PG8_MMA(ai, bj, At, Bt) do { __builtin_amdgcn_s_setprio(1); _Pragma("unroll") for (int m = 0; m < 4; ++m) _Pragma("unroll") for (int n = 0; n < 2; ++n) _Pragma("unroll") for (int k = 0; k < 2; ++k) \
        acc[ai][bj][m][n] = __builtin_amdgcn_mfma_f32_16x16x32_bf16(Bt[n][k], At[m][k], acc[ai][bj][m][n], 0, 0, 0); __builtin_amdgcn_s_setprio(0); } while (0)
#define PG8_WAIT_V(n) asm volatile("s_waitcnt vmcnt(" #n ")" ::: "memory")
#define PG8_WAIT_L(n) asm volatile("s_waitcnt lgkmcnt(" #n ")" ::: "memory")
#define PG8_BAR __builtin_amdgcn_s_barrier()
#define PG8_SCHED __builtin_amdgcn_sched_barrier(0)
    Unit cur, nxt; int ui = 0;
    if (!S.next(0, cur)) return;
    f32x4 acc[2][2][4][2];
#pragma unroll
    for (int a = 0; a < 2; ++a)
#pragma unroll
        for (int b = 0; b < 2; ++b)
#pragma unroll
            for (int m = 0; m < 4; ++m)
#pragma unroll
                for (int n = 0; n < 2; ++n) acc[a][b][m][n] = (f32x4){0.f, 0.f, 0.f, 0.f};
    bf16x8 At[4][2], B0[2][2], B1[2][2];
    const char* cA = (const char*)g.A + (size_t)cur.pm * tstep; const char* cB = (const char*)g.Bt + (size_t)cur.pn * tstep;
    S.a_ready(cur);
    if constexpr (SP2) {
        PG8_STAGE(PG8_SB(0, 0), cB, voffB); PG8_STAGE(PG8_SB(0, 1), cB + hstep, voffB); PG8_STAGE(PG8_SA(0, 0), cA, voffA); PG8_STAGE(PG8_SA(0, 1), cA + hstep, voffA);
        if (wr == 1) PG8_BAR;
        PG8_WAIT_V(2); PG8_BAR;
        PG8_STAGE(PG8_SB(1, 0), cB + kstep, voffB); PG8_STAGE(PG8_SA(1, 0), cA + kstep, voffA); PG8_STAGE(PG8_SB(1, 1), cB + hstep + kstep, voffB);
        PG8_WAIT_V(6); PG8_BAR;
    } else {
        PG8_STAGE(PG8_SB(0, 0), cB, voffB); PG8_STAGE(PG8_SA(0, 0), cA, voffA); PG8_STAGE(PG8_SB(0, 1), cB + hstep, voffB); PG8_STAGE(PG8_SA(0, 1), cA + hstep, voffA);
        if (wr == 1) PG8_BAR;
        PG8_WAIT_V(4); PG8_BAR;
        PG8_STAGE(PG8_SB(1, 0), cB + kstep, voffB); PG8_STAGE(PG8_SA(1, 0), cA + kstep, voffA); PG8_STAGE(PG8_SB(1, 1), cB + hstep + kstep, voffB);
        PG8_WAIT_V(6); PG8_BAR;
    }
    for (;;) {
        const bool has_next = S.next(ui + 1, nxt);
        const char* nA = has_next ? (const char*)g.A + (size_t)nxt.pm * tstep : cA; const char* nB = has_next ? (const char*)g.Bt + (size_t)nxt.pn * tstep : cB;
        for (int t = 0; t < nt; t += 2) {
            const bool last = (t == nt - 2);
            const char* a1 = cA + (size_t)(t + 1) * kstep;
            const char* a2 = last ? nA : cA + (size_t)(t + 2) * kstep; const char* b2 = last ? nB : cB + (size_t)(t + 2) * kstep;
            const char* a3 = a2 + kstep; const char* b3 = b2 + kstep;
            if (last && has_next) S.a_ready(nxt);
            if constexpr (SP2) {
            PG8_LDB(B0, 0, 0); PG8_LDB(B1, 0, 1); PG8_SCHED; PG8_LDA(At, 0, 0); PG8_STAGE(PG8_SA(1, 1), a1 + hstep, voffA);
            PG8_WAIT_V(8); PG8_WAIT_L(0); PG8_BAR; PG8_MMA(0, 0, At, B0); PG8_MMA(0, 1, At, B1); PG8_BAR; PG8_SCHED;
            PG8_LDA(At, 0, 1); PG8_STAGE(PG8_SB(0, 0), b2, voffB); PG8_STAGE(PG8_SB(0, 1), b2 + hstep, voffB); PG8_STAGE(PG8_SA(0, 0), a2, voffA);
            PG8_WAIT_V(8); PG8_WAIT_L(0); PG8_BAR; PG8_MMA(1, 0, At, B0); PG8_MMA(1, 1, At, B1); PG8_BAR; PG8_SCHED;
            PG8_LDB(B0, 1, 0); PG8_LDB(B1, 1, 1); PG8_SCHED; PG8_LDA(At, 1, 0); PG8_STAGE(PG8_SA(0, 1), a2 + hstep, voffA);
            PG8_WAIT_V(8); PG8_WAIT_L(0); PG8_BAR; PG8_MMA(0, 0, At, B0); PG8_MMA(0, 1, At, B1); PG8_BAR; PG8_SCHED;
            PG8_LDA(At, 1, 1); PG8_STAGE(PG8_SB(1, 0), b3, voffB); PG8_STAGE(PG8_SB(1, 1), b3 + hstep, voffB); PG8_STAGE(PG8_SA(1, 0), a3, voffA);
            PG8_WAIT_V(8); PG8_WAIT_L(0); PG8_BAR; PG8_MMA(1, 0, At, B0); PG8_MMA(1, 1, At, B1); PG8_BAR; PG8_SCHED;
            } else {
            PG8_LDB(B0, 0, 0); PG8_SCHED; PG8_LDA(At, 0, 0); PG8_STAGE(PG8_SA(1, 1), a1 + hstep, voffA);
            PG8_WAIT_L(8); PG8_BAR; PG8_WAIT_L(0); PG8_MMA(0, 0, At, B0); PG8_BAR; PG8_SCHED;
            PG8_LDB(B1, 0, 1); PG8_STAGE(PG8_SB(0, 0), b2, voffB);
            PG8_BAR; PG8_WAIT_L(0); PG8_MMA(0, 1, At, B1); PG8_BAR;
            PG8_LDA(At, 0, 1); PG8_STAGE(PG8_SA(0, 0), a2, voffA);
            PG8_BAR; PG8_WAIT_L(0); PG8_MMA(1, 0, At, B0); PG8_BAR; PG8_SCHED;
            PG8_STAGE(PG8_SB(0, 1), b2 + hstep, voffB);
            PG8_WAIT_V(6); PG8_BAR; PG8_MMA(1, 1, At, B1); PG8_BAR;
            PG8_LDB(B0, 1, 0); PG8_SCHED; PG8_LDA(At, 1, 0); PG8_STAGE(PG8_SA(0, 1), a2 + hstep, voffA);
            PG8_WAIT_L(8); PG8_BAR; PG8_WAIT_L(0); PG8_MMA(0, 0, At, B0); PG8_BAR; PG8_SCHED;
            PG8_LDB(B1, 1, 1); PG8_STAGE(PG8_SB(1, 0), b3, voffB);
            PG8_BAR; PG8_WAIT_L(0); PG8_MMA(0, 1, At, B1); PG8_BAR;
            PG8_LDA(At, 1, 1); PG8_STAGE(PG8_SA(1, 0), a3, voffA);
            PG8_BAR; PG8_WAIT_L(0); PG8_MMA(1, 0, At, B0); PG8_BAR; PG8_SCHED;
            PG8_STAGE(PG8_SB(1, 1), b3 + hstep, voffB);
            PG8_WAIT_V(6); PG8_BAR; PG8_MMA(1, 1, At, B1); PG8_BAR;
            }
        }
        if constexpr (ALIGN_EPI) { if (wr == 0) PG8_BAR; }
        if constexpr (!Epi::AFTER_DRAIN) { E(acc, cur, wr, wc, fr, fq); S.done(cur); }
        if (!has_next) break;
#pragma unroll
        for (int a = 0; a < 2; ++a)
#pragma unroll
            for (int b = 0; b < 2; ++b)
#pragma unroll
                for (int m = 0; m < 4; ++m)
#pragma unroll
                    for (int n = 0; n < 2; ++n) acc[a][b][m][n] = (f32x4){0.f, 0.f, 0.f, 0.f};
        cur = nxt; cA = nA; cB = nB; ++ui;
        if constexpr (ALIGN_EPI) { if (wr == 1) PG8_BAR; }
    }
    PG8_WAIT_V(0);
    if constexpr (!ALIGN_EPI) { if (wr == 0) PG8_BAR; }
    PG8_BAR;
    if constexpr (Epi::AFTER_DRAIN) { E.fused(acc, cur, wr, wc, fr, fq, lds, wid, lane); S.done(cur); }
#undef PG8_SA
#undef PG8_SB
#undef PG8_STAGE
#undef PG8_LDA
#undef PG8_LDB
#undef PG8_MMA
#undef PG8_WAIT_V
#undef PG8_WAIT_L
#undef PG8_BAR
#undef PG8_SCHED
}
}

namespace cg = cooperative_groups;
using pg8::bf16_t; using pg8::bf16x8; using pg8::f32x4; using pg8::u32x4; using pg8::cvt_pk_bf16;
#define LAS __attribute__((address_space(3)))
typedef unsigned u32x2 __attribute__((ext_vector_type(2)));

constexpr int NB = 4, SEQ = 8192, DM = 1024, MTOK = NB * SEQ, NLAYER = 4;
constexpr int RW = 512, RWKV_COLS = 1920, IN_COLS = 3456, NPAD1 = 3584, DFF = 2816;
constexpr size_t MiB = 1u << 20;
constexpr size_t WS_W1 = 0, WS_W2 = 7 * MiB, WS_W3 = 9 * MiB, WS_W4 = 20 * MiB, WS_MOD = 26 * MiB, WS_COEF = 27 * MiB, WS_RSTD = 28 * MiB;
constexpr size_t WS_WL = 25 * MiB + 512 * 1024;
constexpr size_t WS_QKG = 29 * MiB;
constexpr size_t WS_BAR = 29 * MiB + 65536;
constexpr size_t WS_U = 30 * MiB;
constexpr size_t WS_QK = 94 * MiB, WS_VT = 158 * MiB;
constexpr size_t WS_R = 94 * MiB, WS_K = 126 * MiB, WS_V = 158 * MiB;
constexpr size_t WS_ZR = 190 * MiB;
constexpr size_t WS_E0 = 318 * MiB, WS_E1 = 350 * MiB, WS_A0 = 382 * MiB, WS_A1 = 414 * MiB;
constexpr size_t WS_DELTA = 318 * MiB;
constexpr size_t WS_ACT = 94 * MiB;
constexpr size_t WS_END = 446 * MiB;
constexpr int LDS_BYTES = 147456;
constexpr int NPHASE = 1 + 10 * NLAYER;

struct Params { const float* in[24]; float* out; unsigned char* ws; int lo, hi; };
enum { I_X = 0, I_C, I_ADAW, I_ADAB, I_N1G, I_N2G, I_WIN, I_MU, I_W0, I_W2, I_A0, I_A2, I_G2, I_KK, I_KA, I_RK, I_LNG, I_LNB, I_QG, I_KG, I_RPB, I_WOUT, I_FIN, I_FOUT };

__device__ __forceinline__ int fresh_tid();
__device__ __forceinline__ __amdgpu_buffer_rsrc_t ws_rsrc(unsigned char* ws) { return __builtin_amdgcn_make_buffer_rsrc(ws, 0, 0x20000000, 0x00020000); }
__device__ __forceinline__ void st16_wt(__amdgpu_buffer_rsrc_t r, size_t off, u32x4 v) { __builtin_amdgcn_raw_buffer_store_b128(v, r, (int)off, 0, 16); }
__device__ __forceinline__ float bf2f(unsigned short v) { return __builtin_bit_cast(float, (unsigned)v << 16); }
__device__ __forceinline__ float bflo(unsigned w) { return __builtin_bit_cast(float, w << 16); }
__device__ __forceinline__ float bfhi(unsigned w) { return __builtin_bit_cast(float, w & 0xffff0000u); }
__device__ __forceinline__ unsigned short f2bf(float f) { return (unsigned short)(cvt_pk_bf16(f, 0.f) & 0xffffu); }
__device__ __forceinline__ float wave_sum(float v) {
#pragma unroll
    for (int o = 32; o >= 1; o >>= 1) v += __shfl_xor(v, o);
    return v;
}
__device__ __forceinline__ float sigmoidf_(float x) { return __builtin_amdgcn_rcpf(1.f + __expf(-x)); }
template <int CTRL> __device__ __forceinline__ float dppf(float x) { return __builtin_bit_cast(float, __builtin_amdgcn_update_dpp(0, __builtin_bit_cast(int, x), CTRL, 0xF, 0xF, false)); }
__device__ __forceinline__ float rowsum16(float x) { x += dppf<0x128>(x); x += dppf<0x124>(x); x += dppf<0x122>(x); x += dppf<0x121>(x); return x; }

__device__ __forceinline__ void phase_mod(const Params& p, float* lds) {
    const int tid = fresh_tid();
    const float* c = p.in[I_C]; const float* aw = p.in[I_ADAW]; const float* ab = p.in[I_ADAB];
    float* mod = (float*)(p.ws + WS_MOD);
    for (int i = tid; i < NB * DM; i += 512) { const float v = c[i]; lds[i] = v / (1.f + __expf(-v)); }
    __syncthreads();
    float* red = lds + NB * DM;
    const int cl = tid & 63, kp = tid >> 6;
    for (int item = blockIdx.x; item < NLAYER * 96; item += gridDim.x) {
        const int l = item / 96, n = (item % 96) * 64 + cl;
        const float* wp = aw + ((size_t)l * DM + kp * 128) * 6144 + n;
        float a0 = 0.f, a1 = 0.f, a2 = 0.f, a3 = 0.f;
#pragma unroll 8
        for (int k = 0; k < 128; ++k) { const float w = wp[(size_t)k * 6144]; const int kk = kp * 128 + k;
            a0 += w * lds[kk]; a1 += w * lds[DM + kk]; a2 += w * lds[2 * DM + kk]; a3 += w * lds[3 * DM + kk]; }
        red[(kp * 4 + 0) * 64 + cl] = a0; red[(kp * 4 + 1) * 64 + cl] = a1; red[(kp * 4 + 2) * 64 + cl] = a2; red[(kp * 4 + 3) * 64 + cl] = a3;
        __syncthreads();
        if (tid < 256) { const int b = tid >> 6; float s = ab[l * 6144 + n];
#pragma unroll
            for (int q = 0; q < 8; ++q) s += red[(q * 4 + b) * 64 + cl];
            mod[(size_t)(l * NB + b) * 6144 + n] = s; }
        __syncthreads();
    }
}

__device__ __forceinline__ void phase_conv(const Params& p, int l, float* tile) {
    const int tid = fresh_tid();
    constexpr int T1 = (NPAD1 / 64) * 16, T2 = 16 * 16, T3 = (2 * DFF / 64) * 16, T4 = 16 * (DFF / 64);
    for (int it = blockIdx.x; it < T1 + T2 + T3 + T4; it += gridDim.x) {
        int mode, nt, kt, K, Nsrc; const float* src; bf16_t* dst;
        if (it < T1) { mode = 1; nt = it / 16; kt = it % 16; K = DM; Nsrc = IN_COLS; src = p.in[I_WIN] + (size_t)l * DM * IN_COLS; dst = (bf16_t*)(p.ws + WS_W1); }
        else if (it < T1 + T2) { const int i2 = it - T1; mode = 2; nt = i2 / 16; kt = i2 % 16; K = DM; Nsrc = DM; src = p.in[I_WOUT] + (size_t)l * DM * DM; dst = (bf16_t*)(p.ws + WS_W2); }
        else if (it < T1 + T2 + T3) { const int i3 = it - T1 - T2; mode = 3; nt = i3 / 16; kt = i3 % 16; K = DM; Nsrc = 2 * DFF; src = p.in[I_FIN] + (size_t)l * DM * 2 * DFF; dst = (bf16_t*)(p.ws + WS_W3); }
        else { const int i4 = it - T1 - T2 - T3; mode = 4; nt = i4 / 44; kt = i4 % 44; K = DFF; Nsrc = DM; src = p.in[I_FOUT] + (size_t)l * DFF * DM; dst = (bf16_t*)(p.ws + WS_W4); }
        {
            const int nn = tid & 63, kk = tid >> 6, np = nt * 64 + nn; int col;
            if (mode == 1) { const int pn = np >> 8, pp = np & 255, bj = pp >> 7, wc = (pp >> 5) & 3, cc = pp & 31; const int L = 256 * pn + 64 * wc + 32 * bj + cc;
                col = L < 1536 ? RWKV_COLS + L : (L < IN_COLS ? L - 1536 : -1); }
            else if (mode == 3) { const int pn = np >> 8, bj = (np >> 7) & 1, i = np & 127; col = bj * DFF + 128 * pn + i; }
            else col = np;
#pragma unroll
            for (int kr = 0; kr < 8; ++kr) { const int k = kk + 8 * kr; tile[k * 65 + nn] = col >= 0 ? src[(size_t)(kt * 64 + k) * Nsrc + col] : 0.f; }
        }
        __syncthreads();
        {
            const int nn = tid >> 3, kc = tid & 7; u32x4 w;
            w.x = cvt_pk_bf16(tile[(8 * kc + 0) * 65 + nn], tile[(8 * kc + 1) * 65 + nn]); w.y = cvt_pk_bf16(tile[(8 * kc + 2) * 65 + nn], tile[(8 * kc + 3) * 65 + nn]);
            w.z = cvt_pk_bf16(tile[(8 * kc + 4) * 65 + nn], tile[(8 * kc + 5) * 65 + nn]); w.w = cvt_pk_bf16(tile[(8 * kc + 6) * 65 + nn], tile[(8 * kc + 7) * 65 + nn]);
            *(u32x4*)(dst + (size_t)(nt * 64 + nn) * K + kt * 64 + 8 * kc) = w;
        }
        __syncthreads();
    }
    {
        bf16_t* WL = (bf16_t*)(p.ws + WS_WL);
        for (int idx = blockIdx.x * 512 + tid; idx < 512 * 48; idx += gridDim.x * 512) { const int col = idx & 511, kc = idx >> 9, k0 = 8 * kc;
            const float* src;
            if (k0 < 128) src = p.in[I_W2] + ((size_t)(l * 2 + (k0 >> 6)) * 64 + (k0 & 63)) * RW + col;
            else if (k0 < 256) src = p.in[I_A2] + ((size_t)(l * 2 + ((k0 - 128) >> 6)) * 64 + (k0 & 63)) * RW + col;
            else src = p.in[I_G2] + ((size_t)l * 128 + (k0 - 256)) * RW + col;
            u32x4 w; w.x = cvt_pk_bf16(src[0], src[RW]); w.y = cvt_pk_bf16(src[2 * RW], src[3 * RW]); w.z = cvt_pk_bf16(src[4 * RW], src[5 * RW]); w.w = cvt_pk_bf16(src[6 * RW], src[7 * RW]);
            *(u32x4*)(WL + (size_t)col * 384 + k0) = w; }
    }
}

__device__ __forceinline__ void phase_norm(const Params& p, int l, int which, const float* h, float* lds) {
    const int tid = fresh_tid(), lane = tid & 63, wave = tid >> 6;
    const float* mod = (const float*)(p.ws + WS_MOD) + (size_t)l * NB * 6144;
    const float* g = p.in[which == 0 ? I_N1G : I_N2G] + l * DM;
    float* gs = lds; float* sh = lds + NB * DM; float* g1 = lds + 2 * NB * DM;
    const bf16_t* delta = (const bf16_t*)(p.ws + WS_DELTA);
    if (which == 0 && blockIdx.x == 0 && tid < 128) ((float*)(p.ws + WS_QKG))[tid] = tid < 64 ? p.in[I_QG][l * 64 + tid] : p.in[I_KG][l * 64 + tid - 64];
    for (int i = tid; i < NB * DM; i += 512) { const int b = i >> 10, k = i & 1023;
        gs[i] = g[k] * (1.f + mod[b * 6144 + (which * 3 + 1) * DM + k]); sh[i] = mod[b * 6144 + (which * 3) * DM + k]; g1[i] = mod[b * 6144 + 2 * DM + k]; }
    __syncthreads();
    bf16_t* u = (bf16_t*)(p.ws + WS_U);
    const int stride = gridDim.x * 8;
    for (int row0 = blockIdx.x * 8 + wave; row0 < MTOK; row0 += 2 * stride) {
        const int row1 = row0 + stride < MTOK ? row0 + stride : row0;
        const float* hr0 = h + (size_t)row0 * DM; const float* hr1 = h + (size_t)row1 * DM;
        f32x4 v0[4], v1[4]; float ss0 = 0.f, ss1 = 0.f;
#pragma unroll
        for (int q = 0; q < 4; ++q) { v0[q] = __builtin_nontemporal_load((const f32x4*)(hr0 + 4 * lane + 256 * q)); v1[q] = __builtin_nontemporal_load((const f32x4*)(hr1 + 4 * lane + 256 * q)); }
        if (which == 1) {
            const int bb0 = row0 >> 13, bb1 = row1 >> 13;
#pragma unroll
            for (int q = 0; q < 4; ++q) { const int k = 4 * lane + 256 * q;
                const u32x2 d0 = *(const u32x2*)(delta + (size_t)row0 * DM + k), d1 = *(const u32x2*)(delta + (size_t)row1 * DM + k);
                const f32x4 ga = *(const f32x4*)(g1 + bb0 * DM + k), gb = *(const f32x4*)(g1 + bb1 * DM + k);
                v0[q] += ga * (f32x4){bflo(d0.x), bfhi(d0.x), bflo(d0.y), bfhi(d0.y)}; v1[q] += gb * (f32x4){bflo(d1.x), bfhi(d1.x), bflo(d1.y), bfhi(d1.y)}; }
        }
#pragma unroll
        for (int q = 0; q < 4; ++q) { ss0 += v0[q][0] * v0[q][0] + v0[q][1] * v0[q][1] + v0[q][2] * v0[q][2] + v0[q][3] * v0[q][3]; ss1 += v1[q][0] * v1[q][0] + v1[q][1] * v1[q][1] + v1[q][2] * v1[q][2] + v1[q][3] * v1[q][3]; }
        ss0 = wave_sum(ss0); ss1 = wave_sum(ss1);
        const float rstd0 = rsqrtf(ss0 * (1.f / DM) + 1e-6f), rstd1 = rsqrtf(ss1 * (1.f / DM) + 1e-6f);
        const int b0 = row0 >> 13, b1 = row1 >> 13;
#pragma unroll
        for (int q = 0; q < 4; ++q) { const int k = 4 * lane + 256 * q;
            { const f32x4 gg = *(const f32x4*)(gs + b0 * DM + k), ss4 = *(const f32x4*)(sh + b0 * DM + k);
              const f32x4 o = v0[q] * rstd0 * gg + ss4; u32x2 w; w.x = cvt_pk_bf16(o[0], o[1]); w.y = cvt_pk_bf16(o[2], o[3]); *(u32x2*)(u + (size_t)row0 * DM + k) = w; }
            { const f32x4 gg = *(const f32x4*)(gs + b1 * DM + k), ss4 = *(const f32x4*)(sh + b1 * DM + k);
              const f32x4 o = v1[q] * rstd1 * gg + ss4; u32x2 w; w.x = cvt_pk_bf16(o[0], o[1]); w.y = cvt_pk_bf16(o[2], o[3]); *(u32x2*)(u + (size_t)row1 * DM + k) = w; }
        }
    }
}

struct EpiZ {
    static constexpr bool PERM = true, AFTER_DRAIN = false;
    unsigned char* ws;
    __device__ __forceinline__ void operator()(const f32x4 (&acc)[2][2][4][2], const pg8::Unit& u, int wr, int wc, int fr, int fq) const {
        const int pn = u.pn, row0 = u.pm * 256 + wr * 64 + fr;
        bf16_t* qk = (bf16_t*)(ws + WS_QK); bf16_t* vT = (bf16_t*)(ws + WS_VT); bf16_t* zr = (bf16_t*)(ws + WS_ZR);
        const __amdgpu_buffer_rsrc_t rs = ws_rsrc(ws);
        if (pn < 4) {
            const float* gg = (const float*)(ws + WS_QKG) + (pn < 2 ? 0 : 64); const float sc = pn < 2 ? 0.125f : 1.f;
            f32x4 gv[2][2];
#pragma unroll
            for (int bj = 0; bj < 2; ++bj)
#pragma unroll
                for (int n = 0; n < 2; ++n) gv[bj][n] = *(const f32x4*)(gg + 32 * bj + 8 * fq + 4 * n) * sc;
            asm volatile("s_waitcnt vmcnt(0)" ::: "memory");
#pragma unroll
            for (int ai = 0; ai < 2; ++ai)
#pragma unroll
                for (int m = 0; m < 4; ++m) {
                    float ss = 0.f;
#pragma unroll
                    for (int bj = 0; bj < 2; ++bj)
#pragma unroll
                        for (int n = 0; n < 2; ++n) { const f32x4 a = acc[ai][bj][m][n]; ss += a[0] * a[0] + a[1] * a[1] + a[2] * a[2] + a[3] * a[3]; }
                    ss += __shfl_xor(ss, 16); ss += __shfl_xor(ss, 32);
                    const float rstd = rsqrtf(ss * (1.f / 64.f) + 1e-6f);
                    bf16_t* rowp = qk + (size_t)(row0 + ai * 128 + m * 16) * 1024 + pn * 256 + 64 * wc + 8 * fq;
#pragma unroll
                    for (int bj = 0; bj < 2; ++bj) { const f32x4 v0 = acc[ai][bj][m][0] * rstd * gv[bj][0], v1 = acc[ai][bj][m][1] * rstd * gv[bj][1];
                        u32x4 w; w.x = cvt_pk_bf16(v0[0], v0[1]); w.y = cvt_pk_bf16(v0[2], v0[3]); w.z = cvt_pk_bf16(v1[0], v1[1]); w.w = cvt_pk_bf16(v1[2], v1[3]);
                        st16_wt(rs, (size_t)((const unsigned char*)(rowp + 32 * bj) - ws), w); }
                }
        } else if (pn < 6) {
            const int h = (pn - 4) * 4 + wc;
#pragma unroll
            for (int ai = 0; ai < 2; ++ai)
#pragma unroll
                for (int m = 0; m < 4; ++m) { const int row = row0 + ai * 128 + m * 16, b = row >> 13, t = row & 8191;
                    bf16_t* base = vT + ((size_t)(b * 8 + h) * 64 + 8 * fq) * SEQ + t;
#pragma unroll
                    for (int bj = 0; bj < 2; ++bj)
#pragma unroll
                        for (int n = 0; n < 2; ++n)
#pragma unroll
                            for (int j = 0; j < 4; ++j) base[(size_t)(32 * bj + 4 * n + j) * SEQ] = f2bf(acc[ai][bj][m][n][j]);
                }
        } else {
            const int colbase = (pn - 6) * 256 + 64 * wc + 8 * fq;
#pragma unroll
            for (int ai = 0; ai < 2; ++ai)
#pragma unroll
                for (int m = 0; m < 4; ++m) { bf16_t* rowp = zr + (size_t)(row0 + ai * 128 + m * 16) * 2048 + colbase;
#pragma unroll
                    for (int bj = 0; bj < 2; ++bj) { const f32x4 v0 = acc[ai][bj][m][0], v1 = acc[ai][bj][m][1];
                        u32x4 w; w.x = cvt_pk_bf16(v0[0], v0[1]); w.y = cvt_pk_bf16(v0[2], v0[3]); w.z = cvt_pk_bf16(v1[0], v1[1]); w.w = cvt_pk_bf16(v1[2], v1[3]);
                        st16_wt(rs, (size_t)((const unsigned char*)(rowp + 32 * bj) - ws), w); }
                }
        }
    }
};

struct EpiRes {
    static constexpr bool PERM = true, AFTER_DRAIN = false;
    const float* hin; float* hout; unsigned char* ws; int gate_off; int gate1_off;
    __device__ __forceinline__ void operator()(const f32x4 (&acc)[2][2][4][2], const pg8::Unit& u, int wr, int wc, int fr, int fq) const {
        const int row0 = u.pm * 256 + wr * 64 + fr, col0 = u.pn * 256 + wc * 32 + 8 * fq, b = (u.pm * 256) >> 13;
        const float* gate = (const float*)(ws + WS_MOD) + gate_off;
        const float* gate1 = (const float*)(ws + WS_MOD) + (gate1_off < 0 ? 0 : gate1_off);
        const bf16_t* delta = (const bf16_t*)(ws + WS_DELTA);
        f32x4 gv[2][2], g1[2][2];
#pragma unroll
        for (int bj = 0; bj < 2; ++bj)
#pragma unroll
            for (int n = 0; n < 2; ++n) { gv[bj][n] = *(const f32x4*)(gate + b * 6144 + col0 + 128 * bj + 4 * n); g1[bj][n] = *(const f32x4*)(gate1 + b * 6144 + col0 + 128 * bj + 4 * n); }
#pragma unroll
        for (int ai = 0; ai < 2; ++ai)
#pragma unroll
            for (int m = 0; m < 4; ++m) { const size_t ro = (size_t)(row0 + ai * 128 + m * 16) * DM + col0;
#pragma unroll
                for (int bj = 0; bj < 2; ++bj) {
                    f32x4 h0 = *(const f32x4*)(hin + ro + 128 * bj), h1 = *(const f32x4*)(hin + ro + 128 * bj + 4);
                    if (gate1_off >= 0) { const u32x4 dw = *(const u32x4*)(delta + ro + 128 * bj);
                        h0 += g1[bj][0] * (f32x4){bflo(dw.x), bfhi(dw.x), bflo(dw.y), bfhi(dw.y)}; h1 += g1[bj][1] * (f32x4){bflo(dw.z), bfhi(dw.z), bflo(dw.w), bfhi(dw.w)}; }
                    *(f32x4*)(hout + ro + 128 * bj) = h0 + gv[bj][0] * acc[ai][bj][m][0];
                    *(f32x4*)(hout + ro + 128 * bj + 4) = h1 + gv[bj][1] * acc[ai][bj][m][1]; }
            }
    }
};

struct EpiDelta {
    static constexpr bool PERM = true, AFTER_DRAIN = false;
    unsigned char* ws;
    __device__ __forceinline__ void operator()(const f32x4 (&acc)[2][2][4][2], const pg8::Unit& u, int wr, int wc, int fr, int fq) const {
        const int row0 = u.pm * 256 + wr * 64 + fr, col0 = u.pn * 256 + wc * 32 + 8 * fq; bf16_t* delta = (bf16_t*)(ws + WS_DELTA);
        const __amdgpu_buffer_rsrc_t rs = ws_rsrc(ws);
#pragma unroll
        for (int ai = 0; ai < 2; ++ai)
#pragma unroll
            for (int m = 0; m < 4; ++m) { bf16_t* rowp = delta + (size_t)(row0 + ai * 128 + m * 16) * DM + col0;
#pragma unroll
                for (int bj = 0; bj < 2; ++bj) { const f32x4 v0 = acc[ai][bj][m][0], v1 = acc[ai][bj][m][1];
                    u32x4 w; w.x = cvt_pk_bf16(v0[0], v0[1]); w.y = cvt_pk_bf16(v0[2], v0[3]); w.z = cvt_pk_bf16(v1[0], v1[1]); w.w = cvt_pk_bf16(v1[2], v1[3]);
                    st16_wt(rs, (size_t)((const unsigned char*)(rowp + 128 * bj) - ws), w); }
            }
    }
};

struct EpiSwiglu {
    static constexpr bool PERM = true, AFTER_DRAIN = false;
    unsigned char* ws;
    __device__ __forceinline__ void operator()(const f32x4 (&acc)[2][2][4][2], const pg8::Unit& u, int wr, int wc, int fr, int fq) const {
        const int row0 = u.pm * 256 + wr * 64 + fr, col0 = u.pn * 128 + wc * 32 + 8 * fq; const __amdgpu_buffer_rsrc_t rs = ws_rsrc(ws);
#pragma unroll
        for (int ai = 0; ai < 2; ++ai)
#pragma unroll
            for (int m = 0; m < 4; ++m) { float o[8];
#pragma unroll
                for (int n = 0; n < 2; ++n)
#pragma unroll
                    for (int j = 0; j < 4; ++j) { const float gte = acc[ai][0][m][n][j], up = acc[ai][1][m][n][j]; o[4 * n + j] = gte * __builtin_amdgcn_rcpf(1.f + __expf(-gte)) * up; }
                u32x4 w; w.x = cvt_pk_bf16(o[0], o[1]); w.y = cvt_pk_bf16(o[2], o[3]); w.z = cvt_pk_bf16(o[4], o[5]); w.w = cvt_pk_bf16(o[6], o[7]);
                st16_wt(rs, WS_ACT + ((size_t)(row0 + ai * 128 + m * 16) * DFF + col0) * 2, w); }
    }
};

struct EpiAny {
    static constexpr bool PERM = true, AFTER_DRAIN = false;
    int mode; unsigned char* ws; const float* hin; float* hout; int gate_off; int gate1_off;
    __device__ __forceinline__ void operator()(const f32x4 (&acc)[2][2][4][2], const pg8::Unit& u, int wr, int wc, int fr, int fq) const {
        if (mode == 0) { EpiZ E{ws}; E(acc, u, wr, wc, fr, fq); }
        else if (mode == 1) { EpiRes E{hin, hout, ws, gate_off, gate1_off}; E(acc, u, wr, wc, fr, fq); }
        else if (mode == 3) { EpiDelta E{ws}; E(acc, u, wr, wc, fr, fq); }
        else { EpiSwiglu E{ws}; E(acc, u, wr, wc, fr, fq); }
    }
};

__device__ __forceinline__ void phase_attn(const Params& p, int l, float* lds) {
    const int tid = fresh_tid(), lane = tid & 63, wave = tid >> 6, fr = lane & 15, fq = lane >> 4;
    const float* rpb = p.in[I_RPB] + (size_t)l * 8 * 15 * 31;
    for (int i = tid; i < 8 * 15 * 31; i += 512) lds[i] = rpb[i];
    __syncthreads();
    const bf16_t* qk = (const bf16_t*)(p.ws + WS_QK); const bf16_t* vT = (const bf16_t*)(p.ws + WS_VT); bf16_t* ymix = (bf16_t*)(p.ws + WS_U);
    for (int task = blockIdx.x * 8 + wave; task < NB * 128 * 8 * 4; task += gridDim.x * 8) {
        const int g = task & 3, h = (task >> 2) & 7, i = (task >> 5) & 127, b = task >> 12;
        const int r0 = min(max(i - 4, 0), 120), c0 = g == 0 ? 0 : (g == 1 ? 8 : (g == 2 ? 24 : 32));
        const int qcol = 16 * g + fr, cs = min(max(qcol - 8, 0), 48);
        const size_t qtok = (size_t)b * SEQ + i * 64 + qcol;
        bf16x8 qf[2];
        qf[0] = *(const bf16x8*)(qk + qtok * 1024 + h * 64 + 8 * fq); qf[1] = *(const bf16x8*)(qk + qtok * 1024 + h * 64 + 32 + 8 * fq);
        const int kcolA = c0 + 8 * (fr >> 2) + (fr & 3);
        const bf16_t* kbase = qk + ((size_t)b * SEQ + r0 * 64 + kcolA) * 1024 + 512 + h * 64 + 8 * fq;
        const bf16_t* vbase = vT + ((size_t)(b * 8 + h) * 64 + fr) * SEQ + r0 * 64 + c0 + 8 * fq;
        bf16x8 kf[8][2][2];
#pragma unroll
        for (int kr = 0; kr < 8; ++kr)
#pragma unroll
            for (int blk = 0; blk < 2; ++blk) { const bf16_t* kp = kbase + (size_t)(kr * 64 + 4 * blk) * 1024; kf[kr][blk][0] = *(const bf16x8*)kp; kf[kr][blk][1] = *(const bf16x8*)(kp + 32); }
        __builtin_amdgcn_sched_barrier(0);
        float sc[8][8];
#pragma unroll
        for (int kr = 0; kr < 8; ++kr)
#pragma unroll
            for (int blk = 0; blk < 2; ++blk) {
                f32x4 a = {0.f, 0.f, 0.f, 0.f};
                a = __builtin_amdgcn_mfma_f32_16x16x32_bf16(kf[kr][blk][0], qf[0], a, 0, 0, 0);
                a = __builtin_amdgcn_mfma_f32_16x16x32_bf16(kf[kr][blk][1], qf[1], a, 0, 0, 0);
#pragma unroll
                for (int j = 0; j < 4; ++j) sc[kr][4 * blk + j] = a[j];
            }
        __builtin_amdgcn_sched_barrier(0);
        bf16x8 vfa[2][8];
#pragma unroll
        for (int db = 0; db < 2; ++db)
#pragma unroll
            for (int kr = 0; kr < 8; ++kr) vfa[db][kr] = *(const bf16x8*)(vbase + (size_t)(16 * db) * SEQ + kr * 64);
        __builtin_amdgcn_sched_barrier(0);
        float mx = -1e30f;
#pragma unroll
        for (int kr = 0; kr < 8; ++kr) { const int ro = r0 + kr - i + 7;
#pragma unroll
            for (int e = 0; e < 8; ++e) { const int kc = c0 + 8 * fq + e; const bool valid = (kc >= cs) && (kc < cs + 16); const int co = min(max(kc - qcol + 15, 0), 30);
                const float s = valid ? sc[kr][e] + lds[(h * 15 + ro) * 31 + co] : -1e30f; sc[kr][e] = s; mx = fmaxf(mx, s); } }
        mx = fmaxf(mx, __shfl_xor(mx, 16)); mx = fmaxf(mx, __shfl_xor(mx, 32));
        float sum = 0.f; bf16x8 pf[8];
#pragma unroll
        for (int kr = 0; kr < 8; ++kr) { float pe[8];
#pragma unroll
            for (int e = 0; e < 8; ++e) { pe[e] = __builtin_amdgcn_exp2f((sc[kr][e] - mx) * 1.4426950408889634f); sum += pe[e]; }
            u32x4 w; w.x = cvt_pk_bf16(pe[0], pe[1]); w.y = cvt_pk_bf16(pe[2], pe[3]); w.z = cvt_pk_bf16(pe[4], pe[5]); w.w = cvt_pk_bf16(pe[6], pe[7]);
            pf[kr] = __builtin_bit_cast(bf16x8, w); }
        sum += __shfl_xor(sum, 16); sum += __shfl_xor(sum, 32);
        const float inv = 1.f / sum;
        __builtin_amdgcn_sched_barrier(0);
        bf16x8 vfb[2][8];
#pragma unroll
        for (int db = 0; db < 2; ++db)
#pragma unroll
            for (int kr = 0; kr < 8; ++kr) vfb[db][kr] = *(const bf16x8*)(vbase + (size_t)(16 * (db + 2)) * SEQ + kr * 64);
        __builtin_amdgcn_sched_barrier(0);
        f32x4 o[4];
#pragma unroll
        for (int db = 0; db < 4; ++db) { o[db] = (f32x4){0.f, 0.f, 0.f, 0.f};
#pragma unroll
            for (int kr = 0; kr < 8; ++kr) o[db] = __builtin_amdgcn_mfma_f32_16x16x32_bf16(db < 2 ? vfa[db & 1][kr] : vfb[db & 1][kr], pf[kr], o[db], 0, 0, 0); }
        asm volatile("s_waitcnt vmcnt(0)" ::: "memory");
#pragma unroll
        for (int db = 0; db < 4; ++db) { u32x2 w; w.x = cvt_pk_bf16(o[db][0] * inv, o[db][1] * inv); w.y = cvt_pk_bf16(o[db][2] * inv, o[db][3] * inv);
            *(u32x2*)(ymix + qtok * 1024 + 512 + h * 64 + 16 * db + 4 * fq) = w; }
    }
}

constexpr int PT = 32, PSTR = 392;
constexpr int PC_OFF = 6400;
__device__ __forceinline__ float fast_tanh(float x) { return 1.f - 2.f * __builtin_amdgcn_rcpf(1.f + __expf(2.f * x)); }
__device__ __forceinline__ void phase_prep(const Params& p, int l, float* ldsf) {
    const int tid = fresh_tid(), wave = __builtin_amdgcn_readfirstlane(tid >> 6);
    bf16_t* lact = (bf16_t*)ldsf;
    float* cmu0 = ldsf + PC_OFF; float* cmu1 = cmu0 + 1920; float* ckk = cmu1 + 1920; float* cka = ckk + 512; float* crk = cka + 512; float* cw0 = crk + 512; float* ca0 = cw0 + 1024;
    const bf16_t* zr = (const bf16_t*)(p.ws + WS_ZR); const bf16_t* WL = (const bf16_t*)(p.ws + WS_WL);
    bf16_t* R = (bf16_t*)(p.ws + WS_R); bf16_t* K = (bf16_t*)(p.ws + WS_K); bf16_t* V = (bf16_t*)(p.ws + WS_V);
    bf16_t* ymix = (bf16_t*)(p.ws + WS_U); float* coef = (float*)(p.ws + WS_COEF); float* rstdp = (float*)(p.ws + WS_RSTD);
    for (int i = tid; i < 3840; i += 512) cmu0[i] = p.in[I_MU][(size_t)l * 3840 + i];
    for (int i = tid; i < 512; i += 512) { ckk[i] = p.in[I_KK][l * RW + i]; cka[i] = p.in[I_KA][l * RW + i]; crk[i] = p.in[I_RK][l * RW + i]; }
    for (int i = tid; i < 1024; i += 512) { cw0[i] = p.in[I_W0][l * 1024 + i]; ca0[i] = p.in[I_A0][l * 1024 + i]; }
    __syncthreads();
    unsigned zc1[12], zp1[12], zn1[12];
#define PREP_S1_LOAD(TILE) do { int t_ = tid; asm volatile("" : "+v"(t_)); \
        _Pragma("unroll") for (int i = 0; i < 12; ++i) { const int idx = t_ + 512 * i, tt = idx / 192, c2 = idx - tt * 192; \
            const bf16_t* zc_p = zr + (size_t)((TILE) * PT + tt) * 2048 + 1536 + 2 * c2; \
            zc1[i] = *(const unsigned*)(zc_p); zp1[i] = *(const unsigned*)(zc_p - 2048); zn1[i] = *(const unsigned*)(zc_p + 2048); } } while (0)
    if ((int)blockIdx.x < MTOK / PT) PREP_S1_LOAD(blockIdx.x);
    for (int tile = blockIdx.x; tile < MTOK / PT; tile += gridDim.x) {
        const int m0 = tile * PT;
        int lane = tid & 63; asm volatile("" : "+v"(lane));
        const int fr = lane & 15, fq = lane >> 4;
        asm volatile("s_waitcnt vmcnt(0)" ::: "memory");
        { int t_ = tid; asm volatile("" : "+v"(t_));
#pragma unroll
        for (int i = 0; i < 12; ++i) { const int idx = t_ + 512 * i, tt = idx / 192, c2 = idx - tt * 192, m = m0 + tt, t = m & 8191, col = 1536 + 2 * c2;
            const unsigned zc = zc1[i], zp = zp1[i], zn = zn1[i];
            const float pmask = t == 0 ? 0.f : 1.f, nmask = t == SEQ - 1 ? 0.f : 1.f;
            const float2 m0v = *(const float2*)(cmu0 + col), m1v = *(const float2*)(cmu1 + col);
            float v0 = bflo(zc) + m0v.x * (bflo(zp) * pmask - bflo(zc)) + m1v.x * (bflo(zn) * nmask - bflo(zc));
            float v1 = bfhi(zc) + m0v.y * (bfhi(zp) * pmask - bfhi(zc)) + m1v.y * (bfhi(zn) * nmask - bfhi(zc));
            if (c2 < 64) { v0 = fast_tanh(v0); v1 = fast_tanh(v1); } else if (c2 >= 128) { v0 = sigmoidf_(v0); v1 = sigmoidf_(v1); }
            *(unsigned*)(lact + tt * PSTR + 2 * c2) = cvt_pk_bf16(v0, v1); } }
        if (tile + (int)gridDim.x < MTOK / PT) PREP_S1_LOAD(tile + gridDim.x);
        __syncthreads();
        f32x4 asum[2][4];
        const bf16_t* wlb = WL + (size_t)(64 * wave + 8 * (fr >> 2) + (fr & 3)) * 384 + 8 * fq;
#pragma unroll
        for (int o = 0; o < 5; ++o) {
            f32x4 acc[2][4];
#pragma unroll
            for (int mb = 0; mb < 2; ++mb)
#pragma unroll
                for (int nb = 0; nb < 4; ++nb) acc[mb][nb] = (f32x4){0.f, 0.f, 0.f, 0.f};
            const int ks0 = o < 4 ? 2 * o : 8;
            bf16x8 wf[4][4];
#pragma unroll
            for (int kk = 0; kk < 4; ++kk)
#pragma unroll
                for (int nb = 0; nb < 4; ++nb) if (kk < (o < 4 ? 2 : 4)) wf[kk][nb] = *(const bf16x8*)(wlb + (size_t)(32 * (nb >> 1) + 4 * (nb & 1)) * 384 + 32 * (ks0 + kk));
            __builtin_amdgcn_sched_barrier(0);
            asm volatile("s_waitcnt vmcnt(0)" ::: "memory");
#pragma unroll
            for (int kk = 0; kk < 4; ++kk) if (kk < (o < 4 ? 2 : 4)) { const int ks = ks0 + kk;
                bf16x8 af[2];
#pragma unroll
                for (int mb = 0; mb < 2; ++mb) af[mb] = *(const bf16x8*)(lact + (16 * mb + fr) * PSTR + 32 * ks + 8 * fq);
#pragma unroll
                for (int mb = 0; mb < 2; ++mb)
#pragma unroll
                    for (int nb = 0; nb < 4; ++nb) acc[mb][nb] = __builtin_amdgcn_mfma_f32_16x16x32_bf16(wf[kk][nb], af[mb], acc[mb][nb], 0, 0, 0);
            }
#pragma unroll
            for (int np = 0; np < 2; ++np) { const int col = 64 * wave + 32 * np + 8 * fq;
                f32x4 bias0 = {0.f, 0.f, 0.f, 0.f}, bias1 = {0.f, 0.f, 0.f, 0.f};
                if (o < 2) { bias0 = *(const f32x4*)(cw0 + o * RW + col); bias1 = *(const f32x4*)(cw0 + o * RW + col + 4); }
                else if (o < 4) { bias0 = *(const f32x4*)(ca0 + (o - 2) * RW + col); bias1 = *(const f32x4*)(ca0 + (o - 2) * RW + col + 4); }
#pragma unroll
                for (int mb = 0; mb < 2; ++mb) { const size_t m = (size_t)(m0 + 16 * mb + fr); f32x4 v0 = acc[mb][2 * np] + bias0, v1 = acc[mb][2 * np + 1] + bias1;
                    if (o < 4) {
#pragma unroll
                        for (int j = 0; j < 4; ++j) { v0[j] = sigmoidf_(v0[j]); v1[j] = sigmoidf_(v1[j]); }
                        if (o < 2) { v0 = v0 * 0.6065306597126334f; v1 = v1 * 0.6065306597126334f; }
                        else if (o == 2) { asum[mb][2 * np] = v0; asum[mb][2 * np + 1] = v1; } else { asum[mb][2 * np] += v0; asum[mb][2 * np + 1] += v1; } }
                    u32x4 w; w.x = cvt_pk_bf16(v0[0], v0[1]); w.y = cvt_pk_bf16(v0[2], v0[3]); w.z = cvt_pk_bf16(v1[0], v1[1]); w.w = cvt_pk_bf16(v1[2], v1[3]);
                    bf16_t* dst = o == 4 ? ymix + m * 1024 + col : (bf16_t*)(p.ws + (o == 0 ? WS_E0 : (o == 1 ? WS_E1 : (o == 2 ? WS_A0 : WS_A1)))) + m * RW + col;
                    *(u32x4*)dst = w; }
            }
            __builtin_amdgcn_sched_barrier(0);
        }
#pragma unroll
        for (int mb = 0; mb < 2; ++mb) { const int m = m0 + 16 * mb + fr, t = m & 8191; float ssq = 0.f, cf = 0.f;
            const int lc = 64 * wave + 8 * fq;
            const bf16_t* zc_p = zr + (size_t)m * 2048 + lc; const bf16_t* zp_p = zc_p - 2048; const bf16_t* zn_p = zc_p + 2048;
            const float pmask = t == 0 ? 0.f : 1.f, nmask = t == SEQ - 1 ? 0.f : 1.f;
            bf16_t* Rp = R + (size_t)m * RW + lc; bf16_t* Kp = K + (size_t)m * RW + lc; bf16_t* Vp = V + (size_t)m * RW + lc;
            u32x4 zcv[2][3], zpv[2][3], znv[2][3];
#pragma unroll
            for (int np = 0; np < 2; ++np)
#pragma unroll
                for (int part = 0; part < 3; ++part) { const int co = part * 512 + 32 * np; zcv[np][part] = *(const u32x4*)(zc_p + co); zpv[np][part] = *(const u32x4*)(zp_p + co); znv[np][part] = *(const u32x4*)(zn_p + co); }
            __builtin_amdgcn_sched_barrier(0);
            asm volatile("s_waitcnt vmcnt(0)" ::: "memory");
#pragma unroll
            for (int np = 0; np < 2; ++np) { float rr[8], kx[8];
#pragma unroll
                for (int part = 0; part < 3; ++part) { const int co = part * 512 + 32 * np;
                    const u32x4 zc = zcv[np][part], zp = zpv[np][part], zn = znv[np][part];
                    float o8[8];
#pragma unroll
                    for (int hf = 0; hf < 2; ++hf) { const f32x4 m0v = *(const f32x4*)(cmu0 + lc + co + 4 * hf), m1v = *(const f32x4*)(cmu1 + lc + co + 4 * hf);
                        const unsigned c0_ = hf ? zc.z : zc.x, c1_ = hf ? zc.w : zc.y, p0_ = hf ? zp.z : zp.x, p1_ = hf ? zp.w : zp.y, n0_ = hf ? zn.z : zn.x, n1_ = hf ? zn.w : zn.y;
                        float c4[4] = {bflo(c0_), bfhi(c0_), bflo(c1_), bfhi(c1_)}, p4[4] = {bflo(p0_), bfhi(p0_), bflo(p1_), bfhi(p1_)}, n4[4] = {bflo(n0_), bfhi(n0_), bflo(n1_), bfhi(n1_)};
#pragma unroll
                        for (int j = 0; j < 4; ++j) o8[4 * hf + j] = c4[j] + m0v[j] * (p4[j] * pmask - c4[j]) + m1v[j] * (n4[j] * nmask - c4[j]); }
                    u32x4 w; w.x = cvt_pk_bf16(o8[0], o8[1]); w.y = cvt_pk_bf16(o8[2], o8[3]); w.z = cvt_pk_bf16(o8[4], o8[5]); w.w = cvt_pk_bf16(o8[6], o8[7]);
                    *(u32x4*)((part == 0 ? Rp : (part == 1 ? Kp : Vp)) + 32 * np) = w;
                    if (part == 0) {
#pragma unroll
                        for (int e = 0; e < 8; ++e) rr[e] = o8[e]; }
                    if (part == 1) {
#pragma unroll
                        for (int e = 0; e < 8; ++e) kx[e] = o8[e]; }
                }
#pragma unroll
                for (int hf = 0; hf < 2; ++hf) { const f32x4 kk4 = *(const f32x4*)(ckk + lc + 32 * np + 4 * hf), ka4 = *(const f32x4*)(cka + lc + 32 * np + 4 * hf), rk4 = *(const f32x4*)(crk + lc + 32 * np + 4 * hf);
#pragma unroll
                    for (int j = 0; j < 4; ++j) { const float kq = kx[4 * hf + j] * kk4[j]; ssq += kq * kq; cf += rr[4 * hf + j] * kx[4 * hf + j] * (2.f + (asum[mb][2 * np + hf][j] - 2.f) * ka4[j]) * rk4[j]; } }
            }
            ssq += __shfl_xor(ssq, 16); ssq += __shfl_xor(ssq, 32); cf += __shfl_xor(cf, 16); cf += __shfl_xor(cf, 32);
            if (fq == 0) { rstdp[(size_t)m * 8 + wave] = 1.f / fmaxf(sqrtf(ssq), 1e-12f); coef[(size_t)m * 8 + wave] = cf; }
            __builtin_amdgcn_sched_barrier(0);
        }
        __syncthreads();
    }
}

constexpr int ST = 32, SSTR = 336;
constexpr int YP_OFF = 2 * ST * SSTR;
typedef float f32x2_t __attribute__((ext_vector_type(2)));
#define SCAN_LOAD(CH, RW_, KW_, EW_, AW_, RS_, VW_) do { \
    _Pragma("unroll") for (int i = 0; i < 4; ++i) { const int tt = sg + 8 * i, s_ = (CH) * ST + tt, t_ = d ? SEQ - 1 - s_ : s_; const size_t m_ = (size_t)b * SEQ + t_; \
        RW_[i] = *(const unsigned*)(R + m_ * RW + h * 64 + 2 * j2); KW_[i] = *(const unsigned*)(K + m_ * RW + h * 64 + 2 * j2); \
        EW_[i] = *(const unsigned*)(E + m_ * RW + h * 64 + 2 * j2); AW_[i] = *(const unsigned*)(A + m_ * RW + h * 64 + 2 * j2); RS_[i] = rstdp[m_ * 8 + h]; } \
    { const int s_ = (CH) * ST + tv, t_ = d ? SEQ - 1 - s_ : s_; const size_t m_ = (size_t)b * SEQ + t_; VW_ = *(const unsigned*)(V + m_ * RW + h * 64 + 16 * rg + 2 * vi2); } } while (0)
__device__ __forceinline__ void phase_scan(const Params& p, int l, float* lds) {
    const int tid = fresh_tid(), lane = tid & 63, wave = tid >> 6;
    const bf16_t* R = (const bf16_t*)(p.ws + WS_R); const bf16_t* K = (const bf16_t*)(p.ws + WS_K); const bf16_t* V = (const bf16_t*)(p.ws + WS_V);
    const float* rstdp = (const float*)(p.ws + WS_RSTD);
    constexpr int NCH = SEQ / ST;
    for (int item = blockIdx.x; item < 256; item += gridDim.x) {
        const int chain = (item & 7) + 8 * (item >> 5), rg = (item >> 3) & 3, d = chain >> 5, b = (chain >> 3) & 3, h = chain & 7;
        const bf16_t* E = (const bf16_t*)(p.ws + (d ? WS_E1 : WS_E0)); const bf16_t* A = (const bf16_t*)(p.ws + (d ? WS_A1 : WS_A0));
        float* ydir = (float*)(p.ws + WS_ZR) + (size_t)d * MTOK * RW;
        if (wave >= 4) {
            const int lt = tid - 256, j2 = lt & 31, sg = lt >> 5, tv = lt >> 3, vi2 = lt & 7;
            const float kk0 = p.in[I_KK][l * RW + h * 64 + 2 * j2], kk1 = p.in[I_KK][l * RW + h * 64 + 2 * j2 + 1];
            const float ka0 = p.in[I_KA][l * RW + h * 64 + 2 * j2], ka1 = p.in[I_KA][l * RW + h * 64 + 2 * j2 + 1];
            unsigned rwA[4], kwA[4], ewA[4], awA[4], vwA; float rsA[4];
            SCAN_LOAD(0, rwA, kwA, ewA, awA, rsA, vwA);
            for (int ch = 0; ch < NCH + 2; ++ch) {
                asm volatile("s_waitcnt vmcnt(0)" ::: "memory");
                if (ch < NCH) {
                    float* buf = lds + (ch & 1) * ST * SSTR;
#pragma unroll
                    for (int i = 0; i < 4; ++i) { const int tt = sg + 8 * i;
                        const float k0 = bflo(kwA[i]), k1 = bfhi(kwA[i]), a0 = bflo(awA[i]), a1 = bfhi(awA[i]);
                        const float q0 = k0 * kk0 * rsA[i], q1 = k1 * kk1 * rsA[i];
                        float* bp = buf + tt * SSTR + 2 * j2;
                        *(float2*)(bp) = make_float2(__expf(-bflo(ewA[i])), __expf(-bfhi(ewA[i])));
                        *(float2*)(bp + 64) = make_float2(k0 * (1.f + (a0 - 1.f) * ka0), k1 * (1.f + (a1 - 1.f) * ka1));
                        *(float2*)(bp + 128) = make_float2(q0 * a0, q1 * a1);
                        *(float2*)(bp + 192) = make_float2(q0, q1);
                        *(float2*)(bp + 256) = make_float2(bflo(rwA[i]), bfhi(rwA[i])); }
                    *(float2*)(buf + tv * SSTR + 320 + 2 * vi2) = make_float2(bflo(vwA), bfhi(vwA));
                }
                if (ch >= 2) {
                    const float* yp = lds + YP_OFF + (((ch & 1) * ST + tv) * 16 + 2 * vi2) * 8;
                    const int rot = (lt >> 2) & 3; float ya = 0.f, yb = 0.f;
#pragma unroll
                    for (int e = 0; e < 4; ++e) { const int c = (e + rot) & 3; const f32x4 pv = *(const f32x4*)(yp + 4 * c); const float sv = (pv[0] + pv[1]) + (pv[2] + pv[3]);
                        ya += c < 2 ? sv : 0.f; yb += c < 2 ? 0.f : sv; }
                    const int s_ = (ch - 2) * ST + tv, t_ = d ? SEQ - 1 - s_ : s_;
                    *(float2*)(ydir + ((size_t)b * SEQ + t_) * RW + h * 64 + 16 * rg + 2 * vi2) = make_float2(ya, yb);
                }
                if (ch + 1 < NCH) SCAN_LOAD(ch + 1, rwA, kwA, ewA, awA, rsA, vwA);
                __syncthreads();
            }
        } else {
            const int cgp = lane >> 4, q = lane & 15;
            f32x2_t s01 = {0.f, 0.f}, s23 = {0.f, 0.f};
            for (int ch = 0; ch < NCH + 2; ++ch) {
                if (ch >= 1 && ch <= NCH) {
                    const float* buf = lds + ((ch - 1) & 1) * ST * SSTR;
                    float* ypw = lds + YP_OFF + ((((ch - 1) & 1) * ST) * 16 + 4 * wave + cgp) * 8 + (q & 7);
                    const float* bq = buf + 4 * q; const float* bvp = buf + 320 + 4 * wave + cgp;
                    f32x4 w4 = *(const f32x4*)(bq), kd = *(const f32x4*)(bq + 64), bv = *(const f32x4*)(bq + 128), kk = *(const f32x4*)(bq + 192), r4 = *(const f32x4*)(bq + 256);
                    float vv = bvp[0];
                    f32x4 w4n = *(const f32x4*)(bq + SSTR), kdn = *(const f32x4*)(bq + SSTR + 64), bvn = *(const f32x4*)(bq + SSTR + 128), kkn = *(const f32x4*)(bq + SSTR + 192), r4n = *(const f32x4*)(bq + SSTR + 256);
                    float vvn = bvp[SSTR];
#pragma unroll
                    for (int tt = 0; tt < ST; ++tt) {
                        const int tn = tt + 2 < ST ? tt + 2 : ST - 1; const float* nb = bq + tn * SSTR;
                        const f32x4 w4m = *(const f32x4*)(nb), kdm = *(const f32x4*)(nb + 64), bvm = *(const f32x4*)(nb + 128), kkm = *(const f32x4*)(nb + 192), r4m = *(const f32x4*)(nb + 256);
                        const float vvm = bvp[tn * SSTR];
                        f32x2_t p2 = s01 * kk.xy; p2 = s23 * kk.zw + p2;
                        float pp = p2.x + p2.y;
                        pp = rowsum16(pp);
                        const f32x2_t vv2 = {vv, vv}, npp = {-pp, -pp};
                        f32x2_t t01 = s01 * w4.xy + vv2 * kd.xy, t23 = s23 * w4.zw + vv2 * kd.zw;
                        s01 = npp * bv.xy + t01; s23 = npp * bv.zw + t23;
                        f32x2_t q2 = s01 * r4.xy; q2 = s23 * r4.zw + q2;
                        float yq = q2.x + q2.y;
                        yq += dppf<0x128>(yq);
                        ypw[tt * 128] = yq;
                        w4 = w4n; kd = kdn; bv = bvn; kk = kkn; r4 = r4n; vv = vvn;
                        w4n = w4m; kdn = kdm; bvn = bvm; kkn = kkm; r4n = r4m; vvn = vvm;
                    }
                }
                __syncthreads();
            }
        }
        __syncthreads();
    }
}

__device__ __forceinline__ void phase_post(const Params& p, int l) {
    const int tid = fresh_tid(), lane = tid & 63, wave = tid >> 6, c = 8 * lane, hd = lane >> 3;
    const float* y0 = (const float*)(p.ws + WS_ZR); const float* y1 = y0 + (size_t)MTOK * RW;
    const bf16_t* V = (const bf16_t*)(p.ws + WS_V); const float* coef = (const float*)(p.ws + WS_COEF); bf16_t* ymix = (bf16_t*)(p.ws + WS_U);
    float lg[8], lb[8];
#pragma unroll
    for (int e = 0; e < 8; ++e) { lg[e] = p.in[I_LNG][l * RW + c + e]; lb[e] = p.in[I_LNB][l * RW + c + e]; }
    const int stride = gridDim.x * 8; const __amdgpu_buffer_rsrc_t wsr = ws_rsrc(p.ws);
    for (int mA = blockIdx.x * 8 + wave; mA < MTOK; mA += 2 * stride) {
        const int mB = mA + stride < MTOK ? mA + stride : mA;
        f32x4 ya[2][2], yb[2][2]; u32x4 vw[2], gw[2]; float cf[2];
#pragma unroll
        for (int r = 0; r < 2; ++r) { const size_t m = (size_t)(r ? mB : mA);
            ya[r][0] = __builtin_nontemporal_load((const f32x4*)(y0 + m * RW + c)); ya[r][1] = __builtin_nontemporal_load((const f32x4*)(y0 + m * RW + c + 4)); yb[r][0] = __builtin_nontemporal_load((const f32x4*)(y1 + m * RW + c)); yb[r][1] = __builtin_nontemporal_load((const f32x4*)(y1 + m * RW + c + 4));
            vw[r] = *(const u32x4*)(V + m * RW + c); gw[r] = *(const u32x4*)(ymix + m * 1024 + c); cf[r] = coef[m * 8 + hd]; }
        asm volatile("s_waitcnt vmcnt(0)" ::: "memory");
#pragma unroll
        for (int r = 0; r < 2; ++r) { const size_t m = (size_t)(r ? mB : mA);
            float y[8];
#pragma unroll
            for (int e = 0; e < 4; ++e) { y[e] = ya[r][0][e] + yb[r][0][e]; y[4 + e] = ya[r][1][e] + yb[r][1][e]; }
            float s1 = 0.f;
#pragma unroll
            for (int e = 0; e < 8; ++e) s1 += y[e];
            s1 += __shfl_xor(s1, 1); s1 += __shfl_xor(s1, 2); s1 += __shfl_xor(s1, 4);
            const float mean = s1 * (1.f / 64.f);
            float s2 = 0.f;
#pragma unroll
            for (int e = 0; e < 8; ++e) { y[e] -= mean; s2 += y[e] * y[e]; }
            s2 += __shfl_xor(s2, 1); s2 += __shfl_xor(s2, 2); s2 += __shfl_xor(s2, 4);
            const float rs = rsqrtf(s2 * (1.f / 64.f) + 64e-5f);
            float o[8];
#pragma unroll
            for (int e = 0; e < 4; ++e) { const unsigned vv = vw[r][e], gg = gw[r][e];
                o[2 * e] = (y[2 * e] * rs * lg[2 * e] + lb[2 * e] + cf[r] * bflo(vv)) * bflo(gg);
                o[2 * e + 1] = (y[2 * e + 1] * rs * lg[2 * e + 1] + lb[2 * e + 1] + cf[r] * bfhi(vv)) * bfhi(gg); }
            u32x4 w; w.x = cvt_pk_bf16(o[0], o[1]); w.y = cvt_pk_bf16(o[2], o[3]); w.z = cvt_pk_bf16(o[4], o[5]); w.w = cvt_pk_bf16(o[6], o[7]);
            if (r == 0 || mB != mA) st16_wt(wsr, WS_U + (m * 1024 + c) * 2, w);
        }
    }
}

__device__ __forceinline__ void fast_grid_barrier(unsigned* bar, unsigned k) {
    asm volatile("s_waitcnt vmcnt(0)" ::: "memory");
    __syncthreads();
    if (threadIdx.x == 0) {
        const unsigned G = gridDim.x, g = blockIdx.x & 7u, ng = G < 8u ? G : 8u, gsz = (G + 7u - g) >> 3;
        __builtin_amdgcn_fence(__ATOMIC_RELEASE, "agent");
        asm volatile("s_waitcnt vmcnt(0)" ::: "memory");
        const unsigned old = __hip_atomic_fetch_add(bar + 64 * (g + 1), 1u, __ATOMIC_RELAXED, __HIP_MEMORY_SCOPE_AGENT);
        if (old + 1u == k * gsz) __hip_atomic_fetch_add(bar, 1u, __ATOMIC_RELAXED, __HIP_MEMORY_SCOPE_AGENT);
        unsigned spins = 0;
        while (__hip_atomic_load(bar, __ATOMIC_RELAXED, __HIP_MEMORY_SCOPE_AGENT) < k * ng) { __builtin_amdgcn_s_sleep(1); if (++spins > (1u << 22)) break; }
        __builtin_amdgcn_fence(__ATOMIC_ACQUIRE, "agent");
        asm volatile("s_waitcnt vmcnt(0)" ::: "memory");
    }
    __syncthreads();
}

#ifndef GA
#define GA true
#endif
#ifndef GS
#define GS true
#endif
#ifndef PROBE_S
#define PROBE_S -1
#endif
#ifndef PHM
#define PHM 0xFFFF
#endif
#ifndef ONE_LAUNCH
#define ONE_LAUNCH 1
#endif
__global__ void __launch_bounds__(512, 2) hybrid_fwd(Params p_) {
    extern __shared__ __attribute__((aligned(16))) unsigned char lds_raw[];
    float* ldsf = (float*)lds_raw;
    LAS unsigned char* ldsa = (LAS unsigned char*)lds_raw;
    const int G = gridDim.x, bx = blockIdx.x;
    const int ph_lo = p_.lo, ph_hi = p_.hi;
    for (int ph = ph_lo; ph < ph_hi; ++ph) {
        typedef const __attribute__((address_space(4))) Params* kparg_t;
        kparg_t pp = (kparg_t)__builtin_amdgcn_kernarg_segment_ptr();
        asm volatile("" : "+s"(pp));
        Params p;
#pragma unroll
        for (int i = 0; i < 24; ++i) p.in[i] = pp->in[i];
        p.out = pp->out; p.ws = pp->ws; p.lo = ph_lo; p.hi = ph_hi;
        if (ph == 0) { if (blockIdx.x == 0 && threadIdx.x < 9) ((unsigned*)(p.ws + WS_BAR))[64 * threadIdx.x] = 0u;
            if (PHM & 0x400) phase_mod(p, ldsf); __syncthreads(); phase_conv(p, 0, ldsf); }
        else {
            const int l = (ph - 1) / 10, s = (ph - 1) % 10;
            for (int rep = 0; rep < (s == PROBE_S ? 2 : 1); ++rep) {
            if (rep) __syncthreads();
            if (s == 1 || s == 6 || s == 8 || s == 9) {
                if (PHM & 2) {
                const int mode = s == 1 ? 0 : (s == 8 ? 2 : (s == 6 ? 3 : 1));
                const size_t aoff = s == 9 ? WS_ACT : WS_U, boff = s == 1 ? WS_W1 : (s == 6 ? WS_W2 : (s == 8 ? WS_W3 : WS_W4));
                const int N = s == 1 ? NPAD1 : (s == 8 ? 2 * DFF : DM), K = s == 9 ? DFF : DM;
                pg8::Gemm g{(const bf16_t*)(p.ws + aoff), (const bf16_t*)(p.ws + boff), MTOK, N, K}; pg8::StaticOrder S; S.init(MTOK, N, G, bx);
                EpiAny E{mode, p.ws, l == 0 ? p.in[I_X] : p.out, p.out, l * NB * 6144 + 5 * DM, l * NB * 6144 + 2 * DM};
                pg8::gemm_phase<EpiAny, pg8::StaticOrder, GA, GS>(ldsa, g, S, E);
                }
            } else switch (s) {
            case 0: if (PHM & 1) { if (l > 0) phase_conv(p, l, ldsf); __syncthreads(); phase_norm(p, l, 0, l == 0 ? p.in[I_X] : p.out, ldsf); } break;
            case 2: if (PHM & 4) phase_attn(p, l, ldsf); break;
            case 3: if (PHM & 8) phase_prep(p, l, ldsf); break;
            case 4: if (PHM & 16) phase_scan(p, l, ldsf); break;
            case 5: if (PHM & 32) phase_post(p, l); break;
            case 7: if (PHM & 128) phase_norm(p, l, 1, l == 0 ? p.in[I_X] : p.out, ldsf); break;
            }
            }
        }
        __syncthreads();
#if ONE_LAUNCH
        if (ph + 1 < ph_hi) { if (ph == 0) cg::this_grid().sync(); else fast_grid_barrier((unsigned*)(p.ws + WS_BAR), (unsigned)ph); }
#endif
    }
}

extern "C" void kernel_launch(void* const* d_in, const int* in_sizes, int n_in, void* d_out, int out_size, void* d_ws, size_t ws_size, hipStream_t stream) {
    static int grid = 0;
    if (grid == 0) {
        if (n_in != 24 || out_size != MTOK * DM || ws_size < WS_END) { fprintf(stderr, "kernel_launch: unexpected shapes / workspace (n_in %d, out %d, ws %zu)\n", n_in, out_size, ws_size); grid = -1; return; }
        int dev = 0, cus = 0;
        if (hipGetDevice(&dev) != hipSuccess || hipDeviceGetAttribute(&cus, hipDeviceAttributeMultiprocessorCount, dev) != hipSuccess) { grid = -1; return; }
        if (hipFuncSetAttribute((const void*)hybrid_fwd, hipFuncAttributeMaxDynamicSharedMemorySize, LDS_BYTES) != hipSuccess) { grid = -1; return; }
        grid = cus;
    }
    if (grid < 0) return;
    Params p{};
    for (int i = 0; i < 24; ++i) p.in[i] = (const float*)d_in[i];
    p.out = (float*)d_out; p.ws = (unsigned char*)d_ws;
#if ONE_LAUNCH
    p.lo = 0; p.hi = NPHASE;
    void* args[] = {&p};
    hipError_t e = hipLaunchCooperativeKernel((const void*)hybrid_fwd, dim3(grid), dim3(512), args, LDS_BYTES, stream);
    if (e != hipSuccess) fprintf(stderr, "cooperative launch failed: %s (grid %d)\n", hipGetErrorString(e), grid);
#else
    for (int ph = 0; ph < NPHASE; ++ph) { p.lo = ph; p.hi = ph + 1; hipLaunchKernelGGL(hybrid_fwd, dim3(grid), dim3(512), LDS_BYTES, stream, p); }
#endif
}
```
